# Optimizing an MI355X kernel written in HIP

```python
import math
import jax, jax.numpy as jnp
from jax import lax
import numpy as np

D_MODEL = 1024
BATCH = 2
SEQ = 8192
DEPTH = 4


N_EVEN = (DEPTH + 1) // 2
N_ODD = DEPTH // 2
N_MEM = 256
RMS_EPS = 1e-6

D_POOL = D_MODEL // 2
POOL_WINDOWS = (2, 4, 8, 16)
N_POOL_GROUPS = len(POOL_WINDOWS)
POOL_GROUP_DIM = D_POOL // N_POOL_GROUPS
D_CONV = D_MODEL // 2
CONV_HEADS = 8
CONV_WIDTH = 3
EVEN_IN = D_POOL + 3 * D_CONV
EVEN_MIX = D_POOL + D_CONV

D_S5 = D_MODEL // 2
S5_GROUP_DIM = 16
S5_GROUPS = D_S5 // S5_GROUP_DIM
S5_STATE = 64
S5_DT_MIN = 1e-3
S5_DT_MAX = 1e-1
D_HYENA = D_MODEL // 2
HYENA_HEADS = 8
HYENA_ORDER = 2
HYENA_BANDS = 16
HYENA_EMB = 2 * HYENA_BANDS + 1
HYENA_FFN = 64
HYENA_TARGET = 1e-2
HYENA_SHORT_DECAY_PCT = 0.3
HYENA_LONG_DECAY_PCT = 1.5
ODD_IN = D_S5 + (HYENA_ORDER + 1) * D_HYENA
ODD_MIX = D_S5 + D_HYENA

XA_HEADS = 4
XA_HEAD_DIM = D_MODEL // XA_HEADS
D_FF = 4 * D_MODEL

kernel_name = 'hybrid_pool_conv_s5_hyena_encoder'


def rms_norm(x, g):
    xf = x.astype(jnp.float32)
    y = xf * lax.rsqrt(jnp.mean(xf * xf, axis=-1, keepdims=True) + RMS_EPS)
    return (y * g.astype(jnp.float32)).astype(x.dtype)


def centred_conv3(u, w):
    up = jnp.pad(u, ((0, 0), (1, 1), (0, 0)))
    return w[0] * up[:, :-2] + w[1] * up[:, 1:-1] + w[2] * up[:, 2:]


def centred_window_mean(u, window):
    L = u.shape[1]
    h = window // 2
    uf = u.astype(jnp.float32)
    cs = jnp.cumsum(jnp.pad(uf, ((0, 0), (h + 1, h), (0, 0))), axis=1)
    s = cs[:, window:window + L] - cs[:, :L]
    t = jnp.arange(L)
    cnt = (jnp.minimum(t + h, L) - jnp.maximum(t - h, 0)).astype(jnp.float32)
    return (s / cnt[None, :, None]).astype(u.dtype)


def pool_mixer(u, w_group, scale):
    B, L, _ = u.shape
    ug = u.reshape(B, L, N_POOL_GROUPS, POOL_GROUP_DIM)
    pooled = jnp.stack([centred_window_mean(ug[:, :, g], win) for g, win in enumerate(POOL_WINDOWS)], axis=2) - ug
    y = jnp.einsum('blgc,gcd->blgd', pooled, w_group).reshape(B, L, D_POOL)
    return y * scale


def short_conv_mixer(b_gate, c_gate, h, conv_w):
    return b_gate * centred_conv3(c_gate * h, conv_w)


def _linear_recurrence(e1, e2):
    a1, b1 = e1
    a2, b2 = e2
    return a1 * a2, a2 * b1 + b2


def s5_mixer(u, lam_re, lam_im, log_dt, b_re, b_im, c_re, c_im, d_skip, w_glu):
    B, L, _ = u.shape
    f32 = jnp.float32
    uf = u.astype(f32)
    lam = lax.complex(jnp.minimum(lam_re.astype(f32), -1e-4), lam_im.astype(f32))
    dt = jnp.exp(log_dt.astype(f32))[..., None]
    lam_bar = jnp.exp(lam * dt)
    coef = (lam_bar - 1.0) / lam
    b_mat = lax.complex(b_re.astype(f32), b_im.astype(f32))
    c_mat = lax.complex(c_re.astype(f32), c_im.astype(f32))
    ug = uf.reshape(B, L, S5_GROUPS, S5_GROUP_DIM).astype(jnp.complex64)
    bu = jnp.einsum('blgh,gnh->blgn', ug, b_mat)
    ys = []
    for direction in range(2):
        a = jnp.broadcast_to(lam_bar[direction], bu.shape)
        _, states = lax.associative_scan(_linear_recurrence, (a, coef[direction] * bu), reverse=(direction == 1), axis=1)
        ys.append(jnp.einsum('blgn,ghn->blgh', states, c_mat[direction]).real)
    y = (ys[0] + ys[1]).reshape(B, L, D_S5) + d_skip.astype(f32) * uf
    g = jax.nn.gelu(y)
    out = g * jax.nn.sigmoid(g @ w_glu.astype(f32))
    return out.astype(u.dtype)


def hyena_filters(L, w1, b1, w2, b2, w3, freq):
    f32 = jnp.float32
    t_norm = jnp.linspace(0.0, 1.0, L, dtype=f32)[:, None]
    bands = jnp.linspace(1e-4, HYENA_BANDS - 1, HYENA_BANDS, dtype=f32)[None, :]
    ang = (2.0 * math.pi / L) * jnp.arange(L, dtype=f32)[:, None] * bands
    z = jnp.concatenate([t_norm, jnp.cos(ang), -jnp.sin(ang)], axis=-1)
    fr = freq.astype(f32)
    h = jnp.sin(fr * (z @ w1.astype(f32) + b1.astype(f32)))
    h = jnp.sin(fr * (h @ w2.astype(f32) + b2.astype(f32)))
    h = (h @ w3.astype(f32)).reshape(L, HYENA_ORDER, 2, D_HYENA)
    deltas = jnp.abs(jnp.linspace(math.log(HYENA_TARGET) / HYENA_LONG_DECAY_PCT, math.log(HYENA_TARGET) / HYENA_SHORT_DECAY_PCT, D_HYENA, dtype=f32))
    h = h * jnp.exp(-t_norm * deltas)[:, None, None, :]
    h = h / (jnp.sum(jnp.abs(h), axis=(0, 2), keepdims=True) + 1e-6)
    fwd = h[:, :, 0]
    bwd = h[:, :, 1]
    k = jnp.concatenate([fwd[:1] + bwd[:1], fwd[1:], jnp.zeros_like(fwd[:1]), bwd[:0:-1]], axis=0)
    return jnp.fft.rfft(k, n=2 * L, axis=0)


def fft_long_conv(u, k_f, bias):
    L = u.shape[1]
    uf = u.astype(jnp.float32)
    y = jnp.fft.irfft(jnp.fft.rfft(uf, n=2 * L, axis=1) * k_f[None], n=2 * L, axis=1)[:, :L]
    return (y + uf * bias.astype(jnp.float32)).astype(u.dtype)


def hyena_mixer(p, short_w, short_b, w1, b1, w2, b2, w3, freq, bias):
    L = p.shape[1]
    p = centred_conv3(p, short_w) + short_b
    g_out, g_mid, v = jnp.split(p, 3, axis=-1)
    k_f = hyena_filters(L, w1, b1, w2, b2, w3, freq)
    z = g_mid * fft_long_conv(v, k_f[:, 0], bias[0])
    return g_out * fft_long_conv(z, k_f[:, 1], bias[1])


def memory_cross_attention(xn, memn, wq, wk, wv, wo):
    B, L, _ = xn.shape
    q = (xn @ wq).reshape(B, L, XA_HEADS, XA_HEAD_DIM)
    k = (memn @ wk).reshape(B, -1, XA_HEADS, XA_HEAD_DIM)
    v = (memn @ wv).reshape(B, -1, XA_HEADS, XA_HEAD_DIM)
    s = jnp.einsum('blhd,bmhd->bhlm', q, k).astype(jnp.float32) * (XA_HEAD_DIM ** -0.5)
    pr = jax.nn.softmax(s, axis=-1).astype(v.dtype)
    o = jnp.einsum('bhlm,bmhd->blhd', pr, v).reshape(B, L, D_MODEL)
    return o @ wo


def squared_relu_mlp(xn, w1, w2):
    h = jax.nn.relu(xn @ w1)
    return (h * h) @ w2


def setup_inputs(seed: int = 0) -> dict:
    key = jax.random.key(seed)
    keys = iter(jax.random.split(key, 48))
    f32 = jnp.float32

    def normal(shape, scale):
        return scale * jax.random.normal(next(keys), shape, f32)

    def gain(shape):
        return 1.0 + normal(shape, 0.05)

    x = normal((BATCH, SEQ, D_MODEL), 1.0)
    mem = normal((BATCH, N_MEM, D_MODEL), 1.0)
    norm_mix = gain((DEPTH, 2, D_MODEL))
    norm_xattn = gain((DEPTH, 2, D_MODEL))
    norm_mem = gain((DEPTH, D_MODEL))
    norm_mlp = gain((DEPTH, 2, D_MODEL))
    xa_wq = normal((DEPTH, D_MODEL, D_MODEL), D_MODEL ** -0.5)
    xa_wk = normal((DEPTH, D_MODEL, D_MODEL), D_MODEL ** -0.5)
    xa_wv = normal((DEPTH, D_MODEL, D_MODEL), D_MODEL ** -0.5)
    xa_wo = normal((DEPTH, D_MODEL, D_MODEL), D_MODEL ** -0.5)
    mlp_w1 = normal((DEPTH, D_MODEL, D_FF), D_MODEL ** -0.5)
    mlp_w2 = normal((DEPTH, D_FF, D_MODEL), D_FF ** -0.5)
    ev_w_in = normal((N_EVEN, D_MODEL, EVEN_IN), D_MODEL ** -0.5)
    ev_pool_w = normal((N_EVEN, N_POOL_GROUPS, POOL_GROUP_DIM, POOL_GROUP_DIM), POOL_GROUP_DIM ** -0.5)
    ev_pool_scale = gain((N_EVEN, D_POOL))
    ev_conv_w = normal((N_EVEN, CONV_WIDTH, D_CONV), CONV_WIDTH ** -0.5)
    ev_w_out = normal((N_EVEN, EVEN_MIX, D_MODEL), EVEN_MIX ** -0.5)
    od_w_in = normal((N_ODD, D_MODEL, ODD_IN), D_MODEL ** -0.5)
    od_s5_lambda_re = -0.5 + normal((N_ODD, 2, S5_GROUPS, S5_STATE), 0.01)
    od_s5_lambda_im = math.pi * jnp.arange(S5_STATE, dtype=f32) + normal((N_ODD, 2, S5_GROUPS, S5_STATE), 0.01)
    od_s5_log_dt = jax.random.uniform(next(keys), (N_ODD, 2, S5_GROUPS), f32, math.log(S5_DT_MIN), math.log(S5_DT_MAX))
    od_s5_b_re = normal((N_ODD, S5_GROUPS, S5_STATE, S5_GROUP_DIM), (2 * S5_GROUP_DIM) ** -0.5)
    od_s5_b_im = normal((N_ODD, S5_GROUPS, S5_STATE, S5_GROUP_DIM), (2 * S5_GROUP_DIM) ** -0.5)
    od_s5_c_re = normal((N_ODD, 2, S5_GROUPS, S5_GROUP_DIM, S5_STATE), (2 * S5_STATE) ** -0.5)
    od_s5_c_im = normal((N_ODD, 2, S5_GROUPS, S5_GROUP_DIM, S5_STATE), (2 * S5_STATE) ** -0.5)
    od_s5_d = normal((N_ODD, D_S5), 1.0)
    od_s5_w_glu = normal((N_ODD, D_S5, D_S5), D_S5 ** -0.5)
    od_hy_short_w = normal((N_ODD, CONV_WIDTH, (HYENA_ORDER + 1) * D_HYENA), CONV_WIDTH ** -0.5)
    od_hy_short_b = normal((N_ODD, (HYENA_ORDER + 1) * D_HYENA), 0.02)
    od_hy_w1 = normal((N_ODD, HYENA_EMB, HYENA_FFN), HYENA_EMB ** -0.5)
    od_hy_b1 = normal((N_ODD, HYENA_FFN), 0.1)
    od_hy_w2 = normal((N_ODD, HYENA_FFN, HYENA_FFN), HYENA_FFN ** -0.5)
    od_hy_b2 = normal((N_ODD, HYENA_FFN), 0.1)
    od_hy_w3 = normal((N_ODD, HYENA_FFN, HYENA_ORDER * 2 * D_HYENA), HYENA_FFN ** -0.5)
    od_hy_freq = gain((N_ODD, HYENA_FFN))
    od_hy_bias = normal((N_ODD, HYENA_ORDER, D_HYENA), 1.0)
    od_w_out = normal((N_ODD, ODD_MIX, D_MODEL), ODD_MIX ** -0.5)
    return {
        'x': x, 'mem': mem,
        'norm_mix': norm_mix, 'norm_xattn': norm_xattn, 'norm_mem': norm_mem, 'norm_mlp': norm_mlp,
        'xa_wq': xa_wq, 'xa_wk': xa_wk, 'xa_wv': xa_wv, 'xa_wo': xa_wo,
        'mlp_w1': mlp_w1, 'mlp_w2': mlp_w2,
        'ev_w_in': ev_w_in, 'ev_pool_w': ev_pool_w, 'ev_pool_scale': ev_pool_scale,
        'ev_conv_w': ev_conv_w, 'ev_w_out': ev_w_out,
        'od_w_in': od_w_in, 'od_s5_lambda_re': od_s5_lambda_re, 'od_s5_lambda_im': od_s5_lambda_im,
        'od_s5_log_dt': od_s5_log_dt, 'od_s5_b_re': od_s5_b_re, 'od_s5_b_im': od_s5_b_im,
        'od_s5_c_re': od_s5_c_re, 'od_s5_c_im': od_s5_c_im, 'od_s5_d': od_s5_d, 'od_s5_w_glu': od_s5_w_glu,
        'od_hy_short_w': od_hy_short_w, 'od_hy_short_b': od_hy_short_b,
        'od_hy_w1': od_hy_w1, 'od_hy_b1': od_hy_b1, 'od_hy_w2': od_hy_w2, 'od_hy_b2': od_hy_b2,
        'od_hy_w3': od_hy_w3, 'od_hy_freq': od_hy_freq, 'od_hy_bias': od_hy_bias,
        'od_w_out': od_w_out,
    }


def reference(x, mem, norm_mix, norm_xattn, norm_mem, norm_mlp, xa_wq, xa_wk, xa_wv, xa_wo, mlp_w1, mlp_w2, ev_w_in, ev_pool_w, ev_pool_scale, ev_conv_w, ev_w_out, od_w_in, od_s5_lambda_re, od_s5_lambda_im, od_s5_log_dt, od_s5_b_re, od_s5_b_im, od_s5_c_re, od_s5_c_im, od_s5_d, od_s5_w_glu, od_hy_short_w, od_hy_short_b, od_hy_w1, od_hy_b1, od_hy_w2, od_hy_b2, od_hy_w3, od_hy_freq, od_hy_bias, od_w_out):
    for i in range(DEPTH):
        j = i // 2
        h = rms_norm(x, norm_mix[i, 0])
        if i % 2 == 0:
            p = h @ ev_w_in[j]
            b_gate, c_gate, hv = jnp.split(p[..., D_POOL:], 3, axis=-1)
            y_pool = pool_mixer(p[..., :D_POOL], ev_pool_w[j], ev_pool_scale[j])
            y_conv = short_conv_mixer(b_gate, c_gate, hv, ev_conv_w[j])
            mix = jnp.concatenate([y_pool, y_conv], axis=-1) @ ev_w_out[j]
        else:
            p = h @ od_w_in[j]
            y_s5 = s5_mixer(p[..., :D_S5], od_s5_lambda_re[j], od_s5_lambda_im[j], od_s5_log_dt[j], od_s5_b_re[j], od_s5_b_im[j], od_s5_c_re[j], od_s5_c_im[j], od_s5_d[j], od_s5_w_glu[j])
            y_hy = hyena_mixer(p[..., D_S5:], od_hy_short_w[j], od_hy_short_b[j], od_hy_w1[j], od_hy_b1[j], od_hy_w2[j], od_hy_b2[j], od_hy_w3[j], od_hy_freq[j], od_hy_bias[j])
            mix = jnp.concatenate([y_s5, y_hy], axis=-1) @ od_w_out[j]
        x = x + rms_norm(mix, norm_mix[i, 1])
        h = rms_norm(x, norm_xattn[i, 0])
        m = rms_norm(mem, norm_mem[i])
        x = x + rms_norm(memory_cross_attention(h, m, xa_wq[i], xa_wk[i], xa_wv[i], xa_wo[i]), norm_xattn[i, 1])
        h = rms_norm(x, norm_mlp[i, 0])
        x = x + rms_norm(squared_relu_mlp(h, mlp_w1[i], mlp_w2[i]), norm_mlp[i, 1])
    return x
```

```cpp
#include <hip/hip_runtime.h>
#include <hip/hip_cooperative_groups.h>
#include <cstdio>
#include <cstdint>
namespace cg = cooperative_groups;

namespace pg8 {
#define PG8_LAS __attribute__((address_space(3)))
typedef unsigned short bf16_t;
typedef short bf16x8 __attribute__((ext_vector_type(8)));
typedef float f32x4 __attribute__((ext_vector_type(4)));
typedef unsigned u32x4 __attribute__((ext_vector_type(4)));
constexpr int BM = 256, BK = 64, HALF = 128, HTB = HALF * BK * 2  , STAGE_BYTES = 8 * HTB, NXCD = 8, WGM = 8;

__host__ __device__ __forceinline__ int lds_byte(int r, int c) { const int st = (r >> 4) * 2 + (c >> 5), rr = r & 15, cc = c & 31, ob = rr * 64 + cc * 2; return st * 1024 + (ob ^ (((ob >> 9) & 1) << 5)); }
__host__ __device__ __forceinline__ void stage_rc(int b, int& R, int& C) { const int st = b / 1024, sb = b % 1024, swz = sb ^ (((sb >> 9) & 1) << 5); R = (st >> 1) * 16 + swz / 64; C = (st & 1) * 32 + (swz % 64) / 2; }
__host__ __device__ __forceinline__ int perm32(int rho) { const int n = rho >> 4, i = rho & 15; return 8 * (i >> 2) + 4 * n + (i & 3); }

struct Unit { int pm, pn; const char* a; const char* b; };
struct Gemm { int K, lda, ldb; };

struct Sched {
    int nM, nN, nwg, G, c; const char* A; const char* Bt; size_t sa_m, sa_n, sb_n, sb_b;
    __device__ __forceinline__ bool next(int i, Unit& u) const {
        const long L = (long)i * G + c; if (L >= nwg) return false;
        int wgid = (int)L; { const int q = nwg / NXCD, r = nwg % NXCD, xcd = wgid % NXCD, off = wgid / NXCD; wgid = (xcd < r ? xcd * (q + 1) : r * (q + 1) + (xcd - r) * q) + off; }
        const int nig = WGM * nN, gid = wgid / nig, fm = gid * WGM, gsz = (nM - fm) < WGM ? (nM - fm) : WGM;
        u.pm = fm + ((wgid % nig) % gsz); u.pn = (wgid % nig) / gsz;
        u.a = A + (size_t)u.pm * sa_m + (size_t)u.pn * sa_n; u.b = Bt + (size_t)u.pn * sb_n + (size_t)(u.pm >> 5) * sb_b; return true;
    }
    __device__ __forceinline__ void a_ready(const Unit&) const {}
    __device__ __forceinline__ void done(const Unit&) const {}
};

__device__ __forceinline__ unsigned cvt_pk_bf16(float lo, float hi) { unsigned r; asm volatile("v_cvt_pk_bf16_f32 %0, %1, %2" : "=v"(r) : "v"(lo), "v"(hi)); return r; }
__device__ __forceinline__ float bfl(unsigned w) { return __uint_as_float(w << 16); }
__device__ __forceinline__ float bfh(unsigned w) { return __uint_as_float(w & 0xffff0000u); }

enum { EP_BF16 = 0, EP_RELU2 = 1, EP_F32S = 2, EP_ODDIN = 3, EP_VT = 4, EP_GLU = 5 };
struct EpiRT {
    static constexpr bool PERM = true, AFTER_DRAIN = false;
    int mode; void* O; void* O2; const void* aux; int ldc; float scale;
    __device__ __forceinline__ void operator()(const f32x4 (&acc)[2][2][4][2], const Unit& u, int wr, int wc, int fr, int fq) const {
#pragma unroll
        for (int ai = 0; ai < 2; ++ai)
#pragma unroll
            for (int m = 0; m < 4; ++m) {
                const int row = u.pm * BM + ai * HALF + wr * 64 + m * 16 + fr;
#pragma unroll
                for (int bj = 0; bj < 2; ++bj) {
                    const int col = u.pn * BM + bj * HALF + wc * 32 + 8 * fq;
                    f32x4 v0 = acc[ai][bj][m][0], v1 = acc[ai][bj][m][1];
                    if (mode == EP_BF16) {
                        u32x4 w; w.x = cvt_pk_bf16(v0[0], v0[1]); w.y = cvt_pk_bf16(v0[2], v0[3]); w.z = cvt_pk_bf16(v1[0], v1[1]); w.w = cvt_pk_bf16(v1[2], v1[3]);
                        *(u32x4*)((bf16_t*)O + (size_t)row * ldc + col) = w;
                    } else if (mode == EP_RELU2) {
#pragma unroll
                        for (int e = 0; e < 4; ++e) { float a = fmaxf(v0[e], 0.f), b = fmaxf(v1[e], 0.f); v0[e] = a * a; v1[e] = b * b; }
                        u32x4 w; w.x = cvt_pk_bf16(v0[0], v0[1]); w.y = cvt_pk_bf16(v0[2], v0[3]); w.z = cvt_pk_bf16(v1[0], v1[1]); w.w = cvt_pk_bf16(v1[2], v1[3]);
                        *(u32x4*)((bf16_t*)O + (size_t)row * ldc + col) = w;
                    } else if (mode == EP_F32S) {
                        float* o = (float*)O + (size_t)row * ldc + col;
                        *(f32x4*)o = v0 * scale; *(f32x4*)(o + 4) = v1 * scale;
                    } else if (mode == EP_ODDIN) {
                        if (col < 512) {
                            u32x4 w; w.x = cvt_pk_bf16(v0[0], v0[1]); w.y = cvt_pk_bf16(v0[2], v0[3]); w.z = cvt_pk_bf16(v1[0], v1[1]); w.w = cvt_pk_bf16(v1[2], v1[3]);
                            *(u32x4*)((bf16_t*)O + (size_t)row * 512 + col) = w;
                        } else {
                            bf16_t* pt = (bf16_t*)O2 + (size_t)(col - 512) * 16384 + row;
#pragma unroll
                            for (int e = 0; e < 4; ++e) { pt[(size_t)e * 16384] = (bf16_t)(cvt_pk_bf16(v0[e], 0.f) & 0xffffu); pt[(size_t)(e + 4) * 16384] = (bf16_t)(cvt_pk_bf16(v1[e], 0.f) & 0xffffu); }
                        }
                    } else if (mode == EP_VT) {
                        bf16_t* vt = (bf16_t*)O + ((size_t)(row >> 8) * 1024 + col) * 256 + (row & 255);
#pragma unroll
                        for (int e = 0; e < 4; ++e) { vt[(size_t)e * 256] = (bf16_t)(cvt_pk_bf16(v0[e], 0.f) & 0xffffu); vt[(size_t)(e + 4) * 256] = (bf16_t)(cvt_pk_bf16(v1[e], 0.f) & 0xffffu); }
                    } else {
                        const u32x4 gw = *(const u32x4*)((const bf16_t*)aux + (size_t)row * 512 + col);
                        float g[8] = {bfl(gw.x), bfh(gw.x), bfl(gw.y), bfh(gw.y), bfl(gw.z), bfh(gw.z), bfl(gw.w), bfh(gw.w)};
                        float o[8];
#pragma unroll
                        for (int e = 0; e < 4; ++e) { o[e] = g[e] / (1.f + __expf(-v0[e])); o[e + 4] = g[e + 4] / (1.f + __expf(-v1[e])); }
                        u32x4 w; w.x = cvt_pk_bf16(o[0], o[1]); w.y = cvt_pk_bf16(o[2], o[3]); w.z = cvt_pk_bf16(o[4], o[5]); w.w = cvt_pk_bf16(o[6], o[7]);
                        *(u32x4*)((bf16_t*)O + (size_t)row * ldc + col) = w;
                    }
                }
            }
    }
};
template <class Epi, class Sched, bool ALIGN_EPI = false, bool SP2 = false>
__device__ __forceinline__ void gemm_phase(PG8_LAS unsigned char* lds, const Gemm g, const Sched& S, const Epi& E, const int tid) {
    const int wid = __builtin_amdgcn_readfirstlane(tid >> 6), lane = tid & 63, wr = wid >> 2, wc = wid & 3, fr = lane & 15, fq = lane >> 4;
    const int K = g.K, nt = K / BK;
    unsigned voffA[2], voffB[2];
#pragma unroll
    for (int i = 0; i < 2; ++i) { int R, C; stage_rc(tid * 16 + i * 8192, R, C); const int Rb = Epi::PERM ? ((R & ~31) + perm32(R & 31)) : R;
        voffA[i] = (unsigned)(R * g.lda + C) * 2u; voffB[i] = (unsigned)(Rb * g.ldb + C) * 2u; }
    const size_t kstep = (size_t)(BK * 2);
    const size_t hstepA = (size_t)HALF * g.lda * 2, hstepB = (size_t)HALF * g.ldb * 2;
    const unsigned ldsw = (unsigned)wid * 1024u;
    const int aoff = lds_byte(wr * 64 + fr, fq * 8), boff = lds_byte(wc * 32 + fr, fq * 8);
#define PG8_SA(b, h) (((b) * 2 + (h)) * HTB)
#define PG8_SB(b, h) ((4 + (b) * 2 + (h)) * HTB)
#define PG8_STAGE(bufoff, gbase, voff) do { _Pragma("unroll") for (int _i = 0; _i < 2; ++_i) \
        __builtin_amdgcn_global_load_lds((const unsigned*)((const char*)(gbase) + (voff)[_i]), (PG8_LAS unsigned*)(lds + (bufoff) + ldsw + _i * 8192), 16, 0, 0); } while (0)
#define PG8_LDA(dst, b, h) do { _Pragma("unroll") for (int m = 0; m < 4; ++m) _Pragma("unroll") for (int k = 0; k < 2; ++k) dst[m][k] = *(const PG8_LAS bf16x8*)(lds + PG8_SA(b, h) + aoff + m * 2048 + k * 1024); } while (0)
#define PG8_LDB(dst, b, h) do { _Pragma("unroll") for (int n = 0; n < 2; ++n) _Pragma("unroll") for (int k = 0; k < 2; ++k) dst[n][k] = *(const PG8_LAS bf16x8*)(lds + PG8_SB(b, h) + boff + n * 2048 + k * 1024); } while (0)
#define PG8_MMA(ai, bj, At, Bt) do { __builtin_amdgcn_s_setprio(1); _Pragma("unroll") for (int m = 0; m < 4; ++m) _Pragma("unroll") for (int n = 0; n < 2; ++n) _Pragma("unroll") for (int k = 0; k < 2; ++k) \
        acc[ai][bj][m][n] = __builtin_amdgcn_mfma_f32_16x16x32_bf16(Bt[n][k], At[m][k], acc[ai][bj][m][n], 0, 0, 0); __builtin_amdgcn_s_setprio(0); } while (0)
#define PG8_WAIT_V(n) asm volatile("s_waitcnt vmcnt(" #n ")" ::: "memory")
#define PG8_WAIT_L(n) asm volatile("s_waitcnt lgkmcnt(" #n ")" ::: "memory")
#define PG8_BAR __builtin_amdgcn_s_barrier()
#define PG8_SCHED __builtin_amdgcn_sched_barrier(0)
    Unit cur, nxt; int ui = 0;
    if (!S.next(0, cur)) return;
    f32x4 acc[2][2][4][2];
#pragma unroll
    for (int a = 0; a < 2; ++a)
#pragma unroll
        for (int b = 0; b < 2; ++b)
#pragma unroll
            for (int m = 0; m < 4; ++m)
#pragma unroll
                for (int n = 0; n < 2; ++n) acc[a][b][m][n] = (f32x4){0.f, 0.f, 0.f, 0.f};
    bf16x8 At[4][2], B0[2][2], B1[2][2];
    const char* cA = cur.a; const char* cB = cur.b;
    S.a_ready(cur);
    if constexpr (SP2) {
        PG8_STAGE(PG8_SB(0, 0), cB, voffB); PG8_STAGE(PG8_SB(0, 1), cB + hstepB, voffB); PG8_STAGE(PG8_SA(0, 0), cA, voffA); PG8_STAGE(PG8_SA(0, 1), cA + hstepA, voffA);
        if (wr == 1) PG8_BAR;
        PG8_WAIT_V(2); PG8_BAR;
        PG8_STAGE(PG8_SB(1, 0), cB + kstep, voffB); PG8_STAGE(PG8_SA(1, 0), cA + kstep, voffA); PG8_STAGE(PG8_SB(1, 1), cB + hstepB + kstep, voffB);
        PG8_WAIT_V(6); PG8_BAR;
    } else {
        PG8_STAGE(PG8_SB(0, 0), cB, voffB); PG8_STAGE(PG8_SA(0, 0), cA, voffA); PG8_STAGE(PG8_SB(0, 1), cB + hstepB, voffB); PG8_STAGE(PG8_SA(0, 1), cA + hstepA, voffA);
        if (wr == 1) PG8_BAR;
        PG8_WAIT_V(4); PG8_BAR;
        PG8_STAGE(PG8_SB(1, 0), cB + kstep, voffB); PG8_STAGE(PG8_SA(1, 0), cA + kstep, voffA); PG8_STAGE(PG8_SB(1, 1), cB + hstepB + kstep, voffB);
        PG8_WAIT_V(6); PG8_BAR;
    }
    for (;;) {
        const bool has_next = S.next(ui + 1, nxt);
        const char* nA = has_next ? nxt.a : cA; const char* nB = has_next ? nxt.b : cB;
        for (int t = 0; t < nt; t += 2) {
            const bool last = (t == nt - 2);
            const char* a1 = cA + (size_t)(t + 1) * kstep;
            const char* a2 = last ? nA : cA + (size_t)(t + 2) * kstep; const char* b2 = last ? nB : cB + (size_t)(t + 2) * kstep;
            const char* a3 = a2 + kstep; const char* b3 = b2 + kstep;
            if (last && has_next) S.a_ready(nxt);
            if constexpr (SP2) {
            PG8_LDB(B0, 0, 0); PG8_LDB(B1, 0, 1); PG8_SCHED; PG8_LDA(At, 0, 0); PG8_STAGE(PG8_SA(1, 1), a1 + hstepA, voffA);
            PG8_WAIT_V(8); PG8_WAIT_L(0); PG8_BAR; PG8_MMA(0, 0, At, B0); PG8_MMA(0, 1, At, B1); PG8_BAR; PG8_SCHED;
            PG8_LDA(At, 0, 1); PG8_STAGE(PG8_SB(0, 0), b2, voffB); PG8_STAGE(PG8_SB(0, 1), b2 + hstepB, voffB); PG8_STAGE(PG8_SA(0, 0), a2, voffA);
            PG8_WAIT_V(8); PG8_WAIT_L(0); PG8_BAR; PG8_MMA(1, 0, At, B0); PG8_MMA(1, 1, At, B1); PG8_BAR; PG8_SCHED;
            PG8_LDB(B0, 1, 0); PG8_LDB(B1, 1, 1); PG8_SCHED; PG8_LDA(At, 1, 0); PG8_STAGE(PG8_SA(0, 1), a2 + hstepA, voffA);
            PG8_WAIT_V(8); PG8_WAIT_L(0); PG8_BAR; PG8_MMA(0, 0, At, B0); PG8_MMA(0, 1, At, B1); PG8_BAR; PG8_SCHED;
            PG8_LDA(At, 1, 1); PG8_STAGE(PG8_SB(1, 0), b3, voffB); PG8_STAGE(PG8_SB(1, 1), b3 + hstepB, voffB); PG8_STAGE(PG8_SA(1, 0), a3, voffA);
            PG8_WAIT_V(8); PG8_WAIT_L(0); PG8_BAR; PG8_MMA(1, 0, At, B0); PG8_MMA(1, 1, At, B1); PG8_BAR; PG8_SCHED;
            } else {
            PG8_LDB(B0, 0, 0); PG8_SCHED; PG8_LDA(At, 0, 0); PG8_STAGE(PG8_SA(1, 1), a1 + hstepA, voffA);
            PG8_WAIT_L(8); PG8_BAR; PG8_WAIT_L(0); PG8_MMA(0, 0, At, B0); PG8_BAR; PG8_SCHED;
            PG8_LDB(B1, 0, 1); PG8_STAGE(PG8_SB(0, 0), b2, voffB);
            PG8_BAR; PG8_WAIT_L(0); PG8_MMA(0, 1, At, B1); PG8_BAR;
            PG8_LDA(At, 0, 1); PG8_STAGE(PG8_SA(0, 0), a2, voffA);
            PG8_BAR; PG8_WAIT_L(0); PG8_MMA(1, 0, At, B0); PG8_BAR; PG8_SCHED;
            PG8_STAGE(PG8_SB(0, 1), b2 + hstepB, voffB);
            PG8_WAIT_V(6); PG8_BAR; PG8_MMA(1, 1, At, B1); PG8_BAR;
            PG8_LDB(B0, 1, 0); PG8_SCHED; PG8_LDA(At, 1, 0); PG8_STAGE(PG8_SA(0, 1), a2 + hstepA, voffA);
            PG8_WAIT_L(8); PG8_BAR; PG8_WAIT_L(0); PG8_MMA(0, 0, At, B0); PG8_BAR; PG8_SCHED;
            PG8_LDB(B1, 1, 1); PG8_STAGE(PG8_SB(1, 0), b3, voffB);
            PG8_BAR; PG8_WAIT_L(0); PG8_MMA(0, 1, At, B1); PG8_BAR;
            PG8_LDA(At, 1, 1); PG8_STAGE(PG8_SA(1, 0), a3, voffA);
            PG8_BAR; PG8_WAIT_L(0); PG8_MMA(1, 0, At, B0); PG8_BAR; PG8_SCHED;
            PG8_STAGE(PG8_SB(1, 1), b3 + hstepB, voffB);
            PG8_WAIT_V(6); PG8_BAR; PG8_MMA(1, 1, At, B1); PG8_BAR;
            }
        }
        if constexpr (ALIGN_EPI) { if (wr == 0) PG8_BAR; }
        if constexpr (!Epi::AFTER_DRAIN) { E(acc, cur, wr, wc, fr, fq); S.done(cur); }
        if (!has_next) break;
#pragma unroll
        for (int a = 0; a < 2; ++a)
#pragma unroll
            for (int b = 0; b < 2; ++b)
#pragma unroll
                for (int m = 0; m < 4; ++m)
#pragma unroll
                    for (int n = 0; n < 2; ++n) acc[a][b][m][n] = (f32x4){0.f, 0.f, 0.f, 0.f};
        cur = nxt; cA = nA; cB = nB; ++ui;
        if constexpr (ALIGN_EPI) { if (wr == 1) PG8_BAR; }
    }
    PG8_WAIT_V(0);
    if constexpr (!ALIGN_EPI) { if (wr == 0) PG8_BAR; }
    PG8_BAR;
    if constexpr (Epi::AFTER_DRAIN) { E.fused(acc, cur, wr, wc, fr, fq, lds, wid, lane); S.done(cur); }
#undef PG8_SA
#undef PG8_SB
#undef PG8_STAGE
#undef PG8_LDA
#undef PG8_LDB
#undef PG8_MMA
#undef PG8_WAIT_V
#undef PG8_WAIT_L
#undef PG8_BAR
#undef PG8_SCHED
}
}

typedef unsigned short bf16;
typedef float f32x4 __attribute__((ext_vector_type(4)));
typedef unsigned u32x4 __attribute__((ext_vector_type(4)));
typedef unsigned u32x2 __attribute__((ext_vector_type(2)));
constexpr int L_SEQ = 8192, T_TOK = 16384, D = 1024, FF = 4096, NMEMT = 512;
constexpr int NFFT = 16384;
constexpr float RMS_EPS = 1e-6f;
constexpr int LDS_BYTES = 147456;
constexpr size_t MiB = 1u << 20;
constexpr size_t WS_NORMS = 0;
constexpr size_t WS_KT0B = 8192;
constexpr size_t WS_TW = 65536;
constexpr size_t WS_S5F = 1 * MiB;
constexpr size_t WS_H2 = 4 * MiB;
constexpr size_t WS_MN = 6 * MiB;
constexpr size_t WS_KB = 7 * MiB;
constexpr size_t WS_VT = 8 * MiB;
constexpr size_t WS_PART = 9 * MiB;
constexpr size_t WS_W = 16 * MiB;
constexpr size_t W_IN = 0, W_OUT = 4 * MiB, W_Q = 6 * MiB, W_K = 8 * MiB, W_V = 10 * MiB, W_O = 12 * MiB, W_1 = 14 * MiB, W_2 = 22 * MiB, W_GLU = 30 * MiB;
constexpr size_t WS_HN = 48 * MiB;
constexpr size_t WS_MIXOUT = 80 * MiB;
constexpr size_t WS_MIXIN = 112 * MiB;
constexpr size_t WS_R = 144 * MiB;
constexpr size_t R_P = 0;
constexpr size_t R_Q = 0, R_SC = 32 * MiB, R_PROB = 96 * MiB;
constexpr size_t R_H = 0;
constexpr size_t R_SPEC = 0, R_KT = 64 * MiB, R_PT = 64 * MiB, R_Y = 64 * MiB, R_PS5 = 112 * MiB, R_G = 128 * MiB, R_YT = 144 * MiB;
constexpr size_t WS_END = WS_R + 160 * MiB;

struct Args { const float* in[37]; float* out; unsigned char* ws; };
constexpr int TAB_OFF = LDS_BYTES - 512;
__device__ __forceinline__ const void* ldptr(const unsigned char* lds, int i) {
    const volatile unsigned* p = (const volatile unsigned*)(lds + TAB_OFF) + 2 * i;
    const unsigned lo = __builtin_amdgcn_readfirstlane(p[0]), hi = __builtin_amdgcn_readfirstlane(p[1]);
    return (const void*)(((unsigned long long)hi << 32) | lo);
}

__device__ __forceinline__ float bf2f(bf16 v) { return __uint_as_float((unsigned)v << 16); }
__device__ __forceinline__ unsigned f2bf(float f) { unsigned u = __float_as_uint(f); return (u + 0x7fffu + ((u >> 16) & 1u)) >> 16; }
__device__ __forceinline__ unsigned pk2(float lo, float hi) { return f2bf(lo) | (f2bf(hi) << 16); }
__device__ __forceinline__ float wave_sum(float v) {
#pragma unroll
    for (int o = 1; o < 64; o <<= 1) v += __shfl_xor(v, o);
    return v;
}
__device__ __forceinline__ float wave_max(float v) {
#pragma unroll
    for (int o = 1; o < 64; o <<= 1) v = fmaxf(v, __shfl_xor(v, o));
    return v;
}
#define LDS_FENCE() asm volatile("s_waitcnt lgkmcnt(0)" ::: "memory")

__device__ __forceinline__ void transpose_item(const float* W, int ldw, int ncols, bf16* WT, int ldt, float* scr, int item, int lane) {
    const int nblk = ncols / 32, kb = item / nblk, nb = item % nblk, k0 = 64 * kb, n0 = 32 * nb;
#pragma unroll 8
    for (int i = 0; i < 32; ++i) { const int kk = 2 * i + (lane >> 5); scr[kk * 33 + (lane & 31)] = W[(size_t)(k0 + kk) * ldw + n0 + (lane & 31)]; }
    LDS_FENCE();
    const int c = lane & 7;
#pragma unroll
    for (int j = 0; j < 4; ++j) { const int n = (lane >> 3) + 8 * j; const float* s = scr + (8 * c) * 33 + n;
        u32x4 o; o.x = pk2(s[0 * 33], s[1 * 33]); o.y = pk2(s[2 * 33], s[3 * 33]); o.z = pk2(s[4 * 33], s[5 * 33]); o.w = pk2(s[6 * 33], s[7 * 33]);
        *(u32x4*)(WT + (size_t)(n0 + n) * ldt + k0 + 8 * c) = o; }
    LDS_FENCE();
}

__device__ __forceinline__ void norm_row(const float* xin, float* xout, const bf16* br, const float* gpost, const float* gpre, bf16* hn, int lane) {
    f32x4 v[4];
#pragma unroll
    for (int j = 0; j < 4; ++j) v[j] = *((const f32x4*)xin + lane + 64 * j);
    if (br) {
        f32x4 r[4]; float ss = 0.f;
#pragma unroll
        for (int j = 0; j < 4; ++j) { const u32x2 w = *((const u32x2*)br + lane + 64 * j);
            r[j] = (f32x4){pg8::bfl(w.x), pg8::bfh(w.x), pg8::bfl(w.y), pg8::bfh(w.y)}; ss += (r[j].x * r[j].x + r[j].y * r[j].y) + (r[j].z * r[j].z + r[j].w * r[j].w); }
        const float rstd = rsqrtf(wave_sum(ss) * (1.f / D) + RMS_EPS);
#pragma unroll
        for (int j = 0; j < 4; ++j) { const f32x4 g = *((const f32x4*)gpost + lane + 64 * j); v[j] = v[j] + r[j] * rstd * g; }
    }
    if (xout) {
#pragma unroll
        for (int j = 0; j < 4; ++j) *((f32x4*)xout + lane + 64 * j) = v[j];
    }
    if (hn) {
        float ss = 0.f;
#pragma unroll
        for (int j = 0; j < 4; ++j) ss += (v[j].x * v[j].x + v[j].y * v[j].y) + (v[j].z * v[j].z + v[j].w * v[j].w);
        const float rstd = rsqrtf(wave_sum(ss) * (1.f / D) + RMS_EPS);
#pragma unroll
        for (int j = 0; j < 4; ++j) { const f32x4 g = *((const f32x4*)gpre + lane + 64 * j); const f32x4 o = v[j] * rstd * g;
            u32x2 w; w.x = pk2(o.x, o.y); w.y = pk2(o.z, o.w); *((u32x2*)hn + lane + 64 * j) = w; }
    }
}

__device__ __forceinline__ void fft_fwd(float2* x, const float2* __restrict__ TW, int tid) {
    for (int ls = 13; ls >= 0; --ls) {
        const int s = 1 << ls;
#pragma unroll 4
        for (int j = tid; j < 8192; j += 512) {
            const int off = j & (s - 1), i = ((j >> ls) << (ls + 1)) + off;
            const float2 a = x[i], b = x[i + s], w = TW[off << (13 - ls)];
            const float dx = a.x - b.x, dy = a.y - b.y;
            x[i] = make_float2(a.x + b.x, a.y + b.y);
            x[i + s] = make_float2(dx * w.x - dy * w.y, dx * w.y + dy * w.x);
        }
        __syncthreads();
    }
}
__device__ __forceinline__ void fft_inv(float2* x, const float2* __restrict__ TW, int tid) {
    for (int ls = 0; ls <= 13; ++ls) {
        const int s = 1 << ls;
#pragma unroll 4
        for (int j = tid; j < 8192; j += 512) {
            const int off = j & (s - 1), i = ((j >> ls) << (ls + 1)) + off;
            const float2 a = x[i], b = x[i + s], w = TW[off << (13 - ls)];
            const float bx = b.x * w.x + b.y * w.y, by = b.y * w.x - b.x * w.y;
            x[i] = make_float2(a.x + bx, a.y + by);
            x[i + s] = make_float2(a.x - bx, a.y - by);
        }
        __syncthreads();
    }
}
__device__ __forceinline__ void spec_mul(float2* x, const unsigned* __restrict__ sp, int tid) {
    for (int p = tid; p < NFFT; p += 512) { const unsigned w = sp[p]; const float kr = pg8::bfl(w), ki = pg8::bfh(w); const float2 a = x[p]; x[p] = make_float2(a.x * kr - a.y * ki, a.x * ki + a.y * kr); }
    __syncthreads();
}
__device__ __forceinline__ float hy_sc(const bf16* r, int t, float w0, float w1, float w2, float sb) {
    float v = w1 * bf2f(r[t]) + sb;
    if (t > 0) v += w0 * bf2f(r[t - 1]);
    if (t < L_SEQ - 1) v += w2 * bf2f(r[t + 1]);
    return v;
}
__device__ __forceinline__ float gelu_tanh(float x) { const float u = 0.7978845608028654f * (x + 0.044715f * x * x * x); return 0.5f * x * (1.f + tanhf(u)); }

enum { OP_CONVERT = 0, OP_F2, OP_F3, OP_GEMM_K, OP_GEMM_V, OP_GEMM_IN, OP_MIX1, OP_MIX2, OP_GEMM_GLU, OP_GEMM_OUT, OP_NORM_MIX, OP_GEMM_Q, OP_GEMM_S, OP_SOFTMAX, OP_GEMM_PV,
       OP_GEMM_O, OP_NORM_XA, OP_GEMM_UP, OP_GEMM_DOWN, OP_NORM_MLP, OP_COUNT };

__global__ void __launch_bounds__(512, 2) fwd_kernel(Args args) {
    extern __shared__ __attribute__((aligned(16))) unsigned char lds[];
    cg::grid_group grid = cg::this_grid();
#define GRID_SYNC() do { asm volatile("s_waitcnt vmcnt(0) lgkmcnt(0)" ::: "memory"); __syncthreads(); grid.sync(); } while (0)
    { const int tid = threadIdx.x;
    if (tid < 37) ((unsigned long long*)(lds + TAB_OFF))[tid] = (unsigned long long)args.in[tid];
    if (tid == 37) ((unsigned long long*)(lds + TAB_OFF))[37] = (unsigned long long)args.out;
    if (tid == 38) ((unsigned long long*)(lds + TAB_OFF))[38] = (unsigned long long)args.ws;
    }
    __syncthreads();
#define INP(i) ((const float*)ldptr(lds, (i)))
    for (int layer_ = 0; layer_ < 4; ++layer_) {
        for (int op = 0; op < OP_COUNT; ++op) {
            int tid = threadIdx.x; asm volatile("" : "+v"(tid));
            int bid = blockIdx.x; asm volatile("" : "+s"(bid));
            int G = gridDim.x; asm volatile("" : "+s"(G));
            int layer = layer_; asm volatile("" : "+s"(layer));
            const int lane = tid & 63, wave = __builtin_amdgcn_readfirstlane(tid >> 6);
            const int gw = bid * 8 + wave, NGW = G * 8, gt = bid * 512 + tid, GT = G * 512;
            const int jj = layer >> 1; const bool odd = (layer & 1) != 0;
            unsigned char* ws = (unsigned char*)ldptr(lds, 38);
            float* X = (float*)ldptr(lds, 37);
            float* KT0B = (float*)(ws + WS_KT0B); float2* TW = (float2*)(ws + WS_TW);
            float2* S5F = (float2*)(ws + WS_S5F); float* H2 = (float*)(ws + WS_H2);
            bf16* MN = (bf16*)(ws + WS_MN); bf16* KB = (bf16*)(ws + WS_KB); bf16* VT = (bf16*)(ws + WS_VT);
            unsigned char* WB = ws + WS_W;
            bf16* HN = (bf16*)(ws + WS_HN); bf16* MIXOUT = (bf16*)(ws + WS_MIXOUT); bf16* MIXIN = (bf16*)(ws + WS_MIXIN);
            unsigned char* R = ws + WS_R;

            bool do_sync = true;
            pg8::Gemm g{0, 0, 0}; pg8::Sched S{}; pg8::EpiRT E{}; bool is_gemm = false;
            S.G = G; S.c = bid; S.sa_n = 0; S.sb_b = 0;
            auto setg = [&](const void* A, int lda, const void* Bt, int ldb, int M, int N, int K) {
                g.K = K; g.lda = lda; g.ldb = ldb; S.nM = M / 256; S.nN = N / 256; S.nwg = S.nM * S.nN; S.A = (const char*)A; S.Bt = (const char*)Bt;
                S.sa_m = (size_t)256 * lda * 2; S.sb_n = (size_t)256 * ldb * 2; is_gemm = true; };
            switch (op) {
            case OP_GEMM_K: setg(MN, D, WB + W_K, D, NMEMT, D, D); E.mode = pg8::EP_BF16; E.O = KB; E.ldc = D; do_sync = false; break;
            case OP_GEMM_V: setg(MN, D, WB + W_V, D, NMEMT, D, D); E.mode = pg8::EP_VT; E.O = VT; do_sync = false; break;
            case OP_GEMM_IN: setg(HN, D, WB + W_IN, D, T_TOK, 2048, D);
                if (!odd) { E.mode = pg8::EP_BF16; E.O = R + R_P; E.ldc = 2048; } else { E.mode = pg8::EP_ODDIN; E.O = R + R_PS5; E.O2 = R + R_PT; } break;
            case OP_GEMM_GLU: if (odd) { setg(R + R_G, 512, WB + W_GLU, 512, T_TOK, 512, 512); E.mode = pg8::EP_GLU; E.O = MIXIN; E.ldc = D; E.aux = R + R_G; } break;
            case OP_GEMM_OUT: setg(MIXIN, D, WB + W_OUT, D, T_TOK, D, D); E.mode = pg8::EP_BF16; E.O = MIXOUT; E.ldc = D; break;
            case OP_GEMM_Q: setg(HN, D, WB + W_Q, D, T_TOK, D, D); E.mode = pg8::EP_BF16; E.O = R + R_Q; E.ldc = D; break;
            case OP_GEMM_S: setg(R + R_Q, D, KB, D, T_TOK, D, 256); S.sa_n = 512; S.sb_n = 512; S.sb_b = (size_t)256 * D * 2;
                E.mode = pg8::EP_F32S; E.O = R + R_SC; E.ldc = D; E.scale = 0.0625f; break;
            case OP_GEMM_PV: setg(R + R_PROB, D, VT, 256, T_TOK, D, 256); S.sa_n = 512; S.sb_n = (size_t)256 * 256 * 2; S.sb_b = (size_t)1024 * 256 * 2;
                E.mode = pg8::EP_BF16; E.O = R + R_Q; E.ldc = D; break;
            case OP_GEMM_O: setg(R + R_Q, D, WB + W_O, D, T_TOK, D, D); E.mode = pg8::EP_BF16; E.O = MIXOUT; E.ldc = D; break;
            case OP_GEMM_UP: setg(HN, D, WB + W_1, D, T_TOK, FF, D); E.mode = pg8::EP_RELU2; E.O = R + R_H; E.ldc = FF; break;
            case OP_GEMM_DOWN: setg(R + R_H, FF, WB + W_2, FF, T_TOK, D, FF); E.mode = pg8::EP_BF16; E.O = MIXOUT; E.ldc = D; break;
            default: break;
            }
            if (is_gemm) {
                pg8::gemm_phase<pg8::EpiRT, pg8::Sched, true, true>((PG8_LAS unsigned char*)lds, g, S, E, tid);
                __syncthreads();
                if (do_sync) GRID_SYNC();
                continue;
            }
            if (op == OP_CONVERT) {
                float* scr = (float*)(lds + wave * 16384);
                const float* Win = odd ? INP(17) + (size_t)jj * D * 2048 : INP(12) + (size_t)jj * D * 2048;
                const float* Wout = odd ? INP(36) + (size_t)jj * D * D : INP(16) + (size_t)jj * D * D;
                const int inc0 = odd ? 0 : 512;
                const int I_IN = (D / 64) * ((2048 - inc0) / 32), I_SQ = (D / 64) * (D / 32), I_1 = (D / 64) * (FF / 32), I_2 = (FF / 64) * (D / 32), I_GLU = odd ? (512 / 64) * (512 / 32) : 0;
                const int NIT = I_IN + 5 * I_SQ + I_1 + I_2 + I_GLU;
                for (int it = gw; it < NIT; it += NGW) {
                    int r = it;
                    if (r < I_IN) { transpose_item(Win + inc0, 2048, 2048 - inc0, (bf16*)(WB + W_IN) + (size_t)inc0 * D, D, scr, r, lane); continue; } r -= I_IN;
                    if (r < I_SQ) { transpose_item(Wout, D, D, (bf16*)(WB + W_OUT), D, scr, r, lane); continue; } r -= I_SQ;
                    if (r < I_SQ) { transpose_item(INP(6) + (size_t)layer * D * D, D, D, (bf16*)(WB + W_Q), D, scr, r, lane); continue; } r -= I_SQ;
                    if (r < I_SQ) { transpose_item(INP(7) + (size_t)layer * D * D, D, D, (bf16*)(WB + W_K), D, scr, r, lane); continue; } r -= I_SQ;
                    if (r < I_SQ) { transpose_item(INP(8) + (size_t)layer * D * D, D, D, (bf16*)(WB + W_V), D, scr, r, lane); continue; } r -= I_SQ;
                    if (r < I_SQ) { transpose_item(INP(9) + (size_t)layer * D * D, D, D, (bf16*)(WB + W_O), D, scr, r, lane); continue; } r -= I_SQ;
                    if (r < I_1) { transpose_item(INP(10) + (size_t)layer * D * FF, FF, FF, (bf16*)(WB + W_1), D, scr, r, lane); continue; } r -= I_1;
                    if (r < I_2) { transpose_item(INP(11) + (size_t)layer * FF * D, D, D, (bf16*)(WB + W_2), FF, scr, r, lane); continue; } r -= I_2;
                    transpose_item(INP(26) + (size_t)jj * 512 * 512, 512, 512, (bf16*)(WB + W_GLU), 512, scr, r, lane);
                }
                if (!odd) {
                    const float* Wg = INP(13) + (size_t)jj * 4 * 128 * 128; const float* psc = INP(14) + (size_t)jj * 512;
                    for (int o = gt; o < D * 512; o += GT) { const int k = o >> 9, n = o & 511, gq = n >> 7, d = n & 127;
                        const float* wr_ = Win + (size_t)k * 2048 + gq * 128; const float* wg = Wg + (size_t)gq * 128 * 128 + d; float acc = 0.f;
#pragma unroll 8
                        for (int c = 0; c < 128; ++c) acc += wr_[c] * wg[c * 128];
                        ((bf16*)(WB + W_IN))[(size_t)n * D + k] = (bf16)f2bf(acc * psc[n]); }
                }
                for (int m = gw; m < NMEMT; m += NGW) norm_row(INP(1) + (size_t)m * D, nullptr, nullptr, nullptr, INP(4) + (size_t)layer * D, MN + (size_t)m * D, lane);
                if (layer == 0) {
                    for (int m = gw; m < T_TOK; m += NGW) norm_row(INP(0) + (size_t)m * D, X + (size_t)m * D, nullptr, nullptr, INP(2), HN + (size_t)m * D, lane);
                    for (int k = gt; k < 8192; k += GT) { float sn, cs; sincospif((float)k * (2.0f / 16384.0f), &sn, &cs); TW[k] = make_float2(cs, -sn); }
                }
                if (odd) {
                    __syncthreads();
                    float* zs = (float*)lds; float* h1s = zs + 8 * 36;
                    const float* w1 = INP(29) + (size_t)jj * 33 * 64; const float* b1 = INP(30) + jj * 64; const float* w2 = INP(31) + (size_t)jj * 64 * 64; const float* b2 = INP(32) + jj * 64; const float* fr = INP(34) + jj * 64;
                    for (int tb = bid; tb < L_SEQ / 8; tb += G) {
                        __syncthreads();
                        if (tid < 8 * 33) { const int tl = tid / 33, k = tid % 33, t = tb * 8 + tl; float z;
                            if (k == 0) z = (float)t / (float)(L_SEQ - 1);
                            else { const int bnd = (k - 1) & 15; const float band = 1e-4f + (float)bnd * ((15.0f - 1e-4f) / 15.0f); const float ang = ((float)(2.0 * 3.14159265358979323846 / L_SEQ) * (float)t) * band;
                                z = (k <= 16) ? cosf(ang) : -sinf(ang); }
                            zs[tl * 36 + k] = z; }
                        __syncthreads();
                        const int tl = tid >> 6, j = tid & 63;
                        { float a = b1[j];
                            for (int k = 0; k < 33; ++k) a += zs[tl * 36 + k] * w1[k * 64 + j];
                            h1s[tl * 64 + j] = sinf(fr[j] * a); }
                        __syncthreads();
                        { float a = b2[j];
                            for (int k = 0; k < 64; ++k) a += h1s[tl * 64 + k] * w2[k * 64 + j];
                            H2[(size_t)(tb * 8 + tl) * 64 + j] = sinf(fr[j] * a); }
                    }
                }
            } else if (op == OP_F2) {
                if (!odd) continue;
                float* hs = (float*)lds; float* KT = (float*)(R + R_KT); float* PART = (float*)(ws + WS_PART);
                const float* w3 = INP(33) + (size_t)jj * 64 * 2048;
                for (int it = bid; it < 512; it += G) {
                    const int tt = it >> 2, cq = it & 3;
                    __syncthreads();
                    for (int e = tid; e < 64 * 64; e += 512) hs[(e >> 6) * 65 + (e & 63)] = H2[(size_t)tt * 4096 + e];
                    __syncthreads();
                    const int t = tt * 64 + lane; const float tn = (float)t / (float)(L_SEQ - 1);
                    for (int i = 0; i < 16; ++i) {
                        const int col = cq * 512 + wave * 64 + 4 * i;
                        float a0 = 0.f, a1 = 0.f, a2 = 0.f, a3 = 0.f;
#pragma unroll 8
                        for (int k = 0; k < 64; ++k) { const float h = hs[lane * 65 + k]; const f32x4 w = *(const f32x4*)(w3 + (size_t)k * 2048 + col); a0 += h * w.x; a1 += h * w.y; a2 += h * w.z; a3 += h * w.w; }
                        const int o = col >> 10, dir = (col >> 9) & 1, c0 = col & 511;
                        float av[4] = {a0, a1, a2, a3};
#pragma unroll
                        for (int e = 0; e < 4; ++e) { const int c = c0 + e;
                            const float lo_ = -4.605170185988091f / 1.5f, hi_ = -4.605170185988091f / 0.3f;
                            const float delta = fabsf(lo_ + (float)c * ((hi_ - lo_) / 511.0f));
                            const float v = av[e] * expf(-tn * delta);
                            const float sa = wave_sum(fabsf(v));
                            if (lane == 0) PART[(size_t)tt * 2048 + col + e] = sa;
                            float* kr = KT + (size_t)(o * 512 + c) * NFFT;
                            if (dir == 0) kr[t] = v; else if (t > 0) kr[NFFT - t] = v; else KT0B[o * 512 + c] = v; }
                    }
                }
            } else if (op == OP_F3) {
                if (!odd) continue;
                float2* x = (float2*)lds; const float* KT = (const float*)(R + R_KT); unsigned* SPEC = (unsigned*)(R + R_SPEC);
                for (int f = bid; f < 1024; f += G) {
                    __syncthreads();
                    const float* kr = KT + (size_t)f * NFFT;
                    for (int p = tid; p < NFFT; p += 512) { float v = (p == L_SEQ) ? 0.f : kr[p]; if (p == 0) v += KT0B[f]; x[p] = make_float2(v, 0.f); }
                    __syncthreads();
                    fft_fwd(x, TW, tid);
                    float nsum; { const float* PART = (const float*)(ws + WS_PART) + (size_t)(f >> 9) * 1024 + (f & 511);
                        nsum = (PART[(size_t)lane * 2048] + PART[(size_t)lane * 2048 + 512]) + (PART[(size_t)(lane + 64) * 2048] + PART[(size_t)(lane + 64) * 2048 + 512]); nsum = wave_sum(nsum); }
                    const float inv = 1.0f / ((nsum + 1e-6f) * (float)NFFT);
                    for (int p = tid; p < NFFT; p += 512) { const float2 a = x[p]; SPEC[(size_t)f * NFFT + p] = pk2(a.x * inv, a.y * inv); }
                }
            } else if (op == OP_MIX1) {
                if (!odd) {
                    const bf16* P = (const bf16*)(R + R_P); const float* cw = INP(15) + (size_t)jj * 3 * 512;
                    for (int item = gt; item < T_TOK * 128; item += GT) {
                        const int row = item >> 7, c8 = item & 127, t = row & (L_SEQ - 1);
                        float o[8];
                        if (c8 < 64) {
                            const int c = c8 * 8, h = 1 << (c >> 7); const int lo = max(t - h, 0), hi = min(t + h, L_SEQ);
                            float s[8] = {0.f, 0.f, 0.f, 0.f, 0.f, 0.f, 0.f, 0.f};
                            const bf16* base = P + (size_t)(row - t) * 2048 + c;
                            for (int tau = lo; tau < hi; ++tau) { const u32x4 w = *(const u32x4*)(base + (size_t)tau * 2048);
                                s[0] += pg8::bfl(w.x); s[1] += pg8::bfh(w.x); s[2] += pg8::bfl(w.y); s[3] += pg8::bfh(w.y); s[4] += pg8::bfl(w.z); s[5] += pg8::bfh(w.z); s[6] += pg8::bfl(w.w); s[7] += pg8::bfh(w.w); }
                            const u32x4 w = *(const u32x4*)(base + (size_t)t * 2048); const float ic = 1.0f / (float)(hi - lo);
                            o[0] = s[0] * ic - pg8::bfl(w.x); o[1] = s[1] * ic - pg8::bfh(w.x); o[2] = s[2] * ic - pg8::bfl(w.y); o[3] = s[3] * ic - pg8::bfh(w.y);
                            o[4] = s[4] * ic - pg8::bfl(w.z); o[5] = s[5] * ic - pg8::bfh(w.z); o[6] = s[6] * ic - pg8::bfl(w.w); o[7] = s[7] * ic - pg8::bfh(w.w);
                        } else {
                            const int c = (c8 - 64) * 8; const bf16* pr = P + (size_t)row * 2048 + c;
                            float acc[8] = {0.f, 0.f, 0.f, 0.f, 0.f, 0.f, 0.f, 0.f};
#pragma unroll
                            for (int dt = -1; dt <= 1; ++dt) {
                                if (t + dt < 0 || t + dt >= L_SEQ) continue;
                                const u32x4 cg_ = *(const u32x4*)(pr + (ptrdiff_t)dt * 2048 + 1024), hv = *(const u32x4*)(pr + (ptrdiff_t)dt * 2048 + 1536);
                                const f32x4 wa = *(const f32x4*)(cw + (dt + 1) * 512 + c), wb = *(const f32x4*)(cw + (dt + 1) * 512 + c + 4);
                                acc[0] += wa.x * pg8::bfl(cg_.x) * pg8::bfl(hv.x); acc[1] += wa.y * pg8::bfh(cg_.x) * pg8::bfh(hv.x); acc[2] += wa.z * pg8::bfl(cg_.y) * pg8::bfl(hv.y); acc[3] += wa.w * pg8::bfh(cg_.y) * pg8::bfh(hv.y);
                                acc[4] += wb.x * pg8::bfl(cg_.z) * pg8::bfl(hv.z); acc[5] += wb.y * pg8::bfh(cg_.z) * pg8::bfh(hv.z); acc[6] += wb.z * pg8::bfl(cg_.w) * pg8::bfl(hv.w); acc[7] += wb.w * pg8::bfh(cg_.w) * pg8::bfh(hv.w);
                            }
                            const u32x4 bg = *(const u32x4*)(pr + 512);
                            o[0] = acc[0] * pg8::bfl(bg.x); o[1] = acc[1] * pg8::bfh(bg.x); o[2] = acc[2] * pg8::bfl(bg.y); o[3] = acc[3] * pg8::bfh(bg.y);
                            o[4] = acc[4] * pg8::bfl(bg.z); o[5] = acc[5] * pg8::bfh(bg.z); o[6] = acc[6] * pg8::bfl(bg.w); o[7] = acc[7] * pg8::bfh(bg.w);
                        }
                        u32x4 w; w.x = pk2(o[0], o[1]); w.y = pk2(o[2], o[3]); w.z = pk2(o[4], o[5]); w.w = pk2(o[6], o[7]);
                        *(u32x4*)(MIXIN + (size_t)row * D + c8 * 8) = w;
                    }
                } else {
                    const bf16* PS5 = (const bf16*)(R + R_PS5);
                    for (int bt = bid; bt < 256; bt += G) {
                        const int bgi = bt & 63, b = bgi >> 5, gq = bgi & 31, chunk = (bt >> 6) * 8 + wave, n = lane;
                        float br[16], bi[16];
                        { const float* pr = INP(21) + ((size_t)(jj * 32 + gq) * 64 + n) * 16; const float* pi = INP(22) + ((size_t)(jj * 32 + gq) * 64 + n) * 16;
#pragma unroll
                            for (int q = 0; q < 4; ++q) { const f32x4 a = *(const f32x4*)(pr + 4 * q), c = *(const f32x4*)(pi + 4 * q);
                                br[4 * q] = a.x; br[4 * q + 1] = a.y; br[4 * q + 2] = a.z; br[4 * q + 3] = a.w; bi[4 * q] = c.x; bi[4 * q + 1] = c.y; bi[4 * q + 2] = c.z; bi[4 * q + 3] = c.w; } }
                        for (int d = 0; d < 2; ++d) {
                            const size_t li = ((size_t)(jj * 2 + d) * 32 + gq) * 64 + n;
                            const float lr = fminf(INP(18)[li], -1e-4f), lim = INP(19)[li], dtv = expf(INP(20)[(jj * 2 + d) * 32 + gq]);
                            const float mag = expf(lr * dtv); float sn, cs; sincosf(lim * dtv, &sn, &cs); const float ar = mag * cs, ai = mag * sn;
                            float sr = 0.f, si = 0.f;
                            const bf16* ub = PS5 + ((size_t)b * L_SEQ + chunk * 256) * 512 + gq * 16;
#pragma unroll 4
                            for (int st = 0; st < 256; ++st) {
                                const int tl = d ? 255 - st : st;
                                const u32x4 u0 = *(const u32x4*)(ub + (size_t)tl * 512), u1 = *(const u32x4*)(ub + (size_t)tl * 512 + 8);
                                const float u[16] = {pg8::bfl(u0.x), pg8::bfh(u0.x), pg8::bfl(u0.y), pg8::bfh(u0.y), pg8::bfl(u0.z), pg8::bfh(u0.z), pg8::bfl(u0.w), pg8::bfh(u0.w),
                                                     pg8::bfl(u1.x), pg8::bfh(u1.x), pg8::bfl(u1.y), pg8::bfh(u1.y), pg8::bfl(u1.z), pg8::bfh(u1.z), pg8::bfl(u1.w), pg8::bfh(u1.w)};
                                float bur = 0.f, bui = 0.f;
#pragma unroll
                                for (int q = 0; q < 16; ++q) { bur += br[q] * u[q]; bui += bi[q] * u[q]; }
                                const float nr = ar * sr - ai * si + bur, ni = ar * si + ai * sr + bui; sr = nr; si = ni;
                            }
                            S5F[((((size_t)d * 2 + b) * 32 + gq) * 32 + chunk) * 64 + n] = make_float2(sr, si);
                        }
                    }
                    __syncthreads();
                    float2* x = (float2*)lds; const bf16* PT = (const bf16*)(R + R_PT); const unsigned* SPEC = (const unsigned*)(R + R_SPEC); bf16* YT = (bf16*)(R + R_YT);
                    const float* sw = INP(27) + (size_t)jj * 3 * 1536; const float* sbv = INP(28) + (size_t)jj * 1536; const float* hb = INP(35) + (size_t)jj * 2 * 512;
                    for (int c = bid; c < 512; c += G) {
                        const bf16* r_go = PT + (size_t)c * T_TOK; const bf16* r_gm = PT + (size_t)(512 + c) * T_TOK; const bf16* r_v = PT + (size_t)(1024 + c) * T_TOK;
                        const float go0 = sw[c], go1 = sw[1536 + c], go2 = sw[3072 + c], gob = sbv[c];
                        const float gm0 = sw[512 + c], gm1 = sw[1536 + 512 + c], gm2 = sw[3072 + 512 + c], gmb = sbv[512 + c];
                        const float v0 = sw[1024 + c], v1 = sw[1536 + 1024 + c], v2 = sw[3072 + 1024 + c], vb = sbv[1024 + c];
                        const float bias0 = hb[c], bias1 = hb[512 + c];
                        __syncthreads();
                        for (int t = tid; t < L_SEQ; t += 512) { x[t] = make_float2(hy_sc(r_v, t, v0, v1, v2, vb), hy_sc(r_v + L_SEQ, t, v0, v1, v2, vb)); x[L_SEQ + t] = make_float2(0.f, 0.f); }
                        __syncthreads();
                        fft_fwd(x, TW, tid); spec_mul(x, SPEC + (size_t)c * NFFT, tid); fft_inv(x, TW, tid);
                        float2 zr[16];
#pragma unroll
                        for (int i = 0; i < 16; ++i) { const int t = tid + 512 * i; const float2 y1 = x[t];
                            const float va = hy_sc(r_v, t, v0, v1, v2, vb), vbb = hy_sc(r_v + L_SEQ, t, v0, v1, v2, vb);
                            const float ga = hy_sc(r_gm, t, gm0, gm1, gm2, gmb), gb = hy_sc(r_gm + L_SEQ, t, gm0, gm1, gm2, gmb);
                            zr[i] = make_float2(ga * (y1.x + va * bias0), gb * (y1.y + vbb * bias0));
                            x[t] = zr[i]; x[L_SEQ + t] = make_float2(0.f, 0.f); }
                        __syncthreads();
                        fft_fwd(x, TW, tid); spec_mul(x, SPEC + (size_t)(512 + c) * NFFT, tid); fft_inv(x, TW, tid);
#pragma unroll
                        for (int i = 0; i < 16; ++i) { const int t = tid + 512 * i; const float2 y2 = x[t];
                            const float ga = hy_sc(r_go, t, go0, go1, go2, gob), gb = hy_sc(r_go + L_SEQ, t, go0, go1, go2, gob);
                            YT[(size_t)c * T_TOK + t] = (bf16)f2bf(ga * (y2.x + zr[i].x * bias1));
                            YT[(size_t)c * T_TOK + L_SEQ + t] = (bf16)f2bf(gb * (y2.y + zr[i].y * bias1)); }
                    }
                }
            } else if (op == OP_MIX2) {
                if (!odd) continue;
                const bf16* PS5 = (const bf16*)(R + R_PS5); float* Y = (float*)(R + R_Y); bf16* Gb = (bf16*)(R + R_G);
                float2* CL = (float2*)lds; float2* tile = (float2*)(lds + 16384) + wave * (16 * 65);
                for (int bt = bid; bt < 256; bt += G) {
                    const int bgi = bt & 63, b = bgi >> 5, gq = bgi & 31, chunk = (bt >> 6) * 8 + wave, n = lane;
                    __syncthreads();
                    for (int e = tid; e < 2048; e += 512) { const int d = e >> 10, nn = (e >> 4) & 63, h = e & 15;
                        const size_t li = ((size_t)(jj * 2 + d) * 32 + gq) * 64 + nn;
                        const float lr = fminf(INP(18)[li], -1e-4f), lim = INP(19)[li], dtv = expf(INP(20)[(jj * 2 + d) * 32 + gq]);
                        const float mag = expf(lr * dtv); float sn, cs; sincosf(lim * dtv, &sn, &cs); const float ar = mag * cs - 1.f, ai = mag * sn;
                        const float den = 1.f / (lr * lr + lim * lim); const float cr = (ar * lr + ai * lim) * den, ci = (ai * lr - ar * lim) * den;
                        const size_t cidx = (((size_t)(jj * 2 + d) * 32 + gq) * 16 + h) * 64 + nn; const float xr = INP(23)[cidx], xi = INP(24)[cidx];
                        CL[e] = make_float2(xr * cr - xi * ci, xr * ci + xi * cr); }
                    __syncthreads();
                    float br[16], bi[16];
                    { const float* pr = INP(21) + ((size_t)(jj * 32 + gq) * 64 + n) * 16; const float* pi = INP(22) + ((size_t)(jj * 32 + gq) * 64 + n) * 16;
#pragma unroll
                        for (int q = 0; q < 4; ++q) { const f32x4 a = *(const f32x4*)(pr + 4 * q), c = *(const f32x4*)(pi + 4 * q);
                            br[4 * q] = a.x; br[4 * q + 1] = a.y; br[4 * q + 2] = a.z; br[4 * q + 3] = a.w; bi[4 * q] = c.x; bi[4 * q + 1] = c.y; bi[4 * q + 2] = c.z; bi[4 * q + 3] = c.w; } }
                    const int tl16 = lane & 15, hq = lane >> 4;
                    const f32x4 dsk = *(const f32x4*)(INP(25) + (size_t)jj * 512 + gq * 16 + 4 * hq);
                    for (int d = 0; d < 2; ++d) {
                        if (d) { __threadfence_block(); asm volatile("s_waitcnt vmcnt(0)" ::: "memory"); }
                        const size_t li = ((size_t)(jj * 2 + d) * 32 + gq) * 64 + n;
                        const float lr = fminf(INP(18)[li], -1e-4f), lim = INP(19)[li], dtv = expf(INP(20)[(jj * 2 + d) * 32 + gq]);
                        const float mag = expf(lr * dtv); float sn, cs; sincosf(lim * dtv, &sn, &cs); const float ar = mag * cs, ai = mag * sn;
                        float pr_ = ar, pi_ = ai;
#pragma unroll
                        for (int q = 0; q < 8; ++q) { const float t0 = pr_ * pr_ - pi_ * pi_, t1 = 2.f * pr_ * pi_; pr_ = t0; pi_ = t1; }
                        float sr = 0.f, si = 0.f;
                        const float2* Fb = S5F + ((((size_t)d * 2 + b) * 32 + gq) * 32) * 64 + n;
                        if (d == 0) { for (int cc = 0; cc < chunk; ++cc) { const float2 f = Fb[(size_t)cc * 64]; const float nr = pr_ * sr - pi_ * si + f.x, ni = pr_ * si + pi_ * sr + f.y; sr = nr; si = ni; } }
                        else { for (int cc = 31; cc > chunk; --cc) { const float2 f = Fb[(size_t)cc * 64]; const float nr = pr_ * sr - pi_ * si + f.x, ni = pr_ * si + pi_ * sr + f.y; sr = nr; si = ni; } }
                        const size_t rowc = (size_t)b * L_SEQ + chunk * 256;
                        const bf16* ub = PS5 + rowc * 512 + gq * 16;
                        const float2* CLd = CL + d * 1024;
                        for (int sc = 0; sc < 16; ++sc) {
#pragma unroll 4
                            for (int i = 0; i < 16; ++i) {
                                const int st = sc * 16 + i, tl = d ? 255 - st : st;
                                const u32x4 u0 = *(const u32x4*)(ub + (size_t)tl * 512), u1 = *(const u32x4*)(ub + (size_t)tl * 512 + 8);
                                const float u[16] = {pg8::bfl(u0.x), pg8::bfh(u0.x), pg8::bfl(u0.y), pg8::bfh(u0.y), pg8::bfl(u0.z), pg8::bfh(u0.z), pg8::bfl(u0.w), pg8::bfh(u0.w),
                                                     pg8::bfl(u1.x), pg8::bfh(u1.x), pg8::bfl(u1.y), pg8::bfh(u1.y), pg8::bfl(u1.z), pg8::bfh(u1.z), pg8::bfl(u1.w), pg8::bfh(u1.w)};
                                float bur = 0.f, bui = 0.f;
#pragma unroll
                                for (int q = 0; q < 16; ++q) { bur += br[q] * u[q]; bui += bi[q] * u[q]; }
                                const float nr = ar * sr - ai * si + bur, ni = ar * si + ai * sr + bui; sr = nr; si = ni;
                                tile[i * 65 + n] = make_float2(sr, si);
                            }
                            LDS_FENCE();
                            float a0 = 0.f, a1 = 0.f, a2 = 0.f, a3 = 0.f;
#pragma unroll 8
                            for (int nn = 0; nn < 64; ++nn) { const float2 s = tile[tl16 * 65 + nn]; const f32x4 c01 = *(const f32x4*)(CLd + nn * 16 + 4 * hq), c23 = *(const f32x4*)(CLd + nn * 16 + 4 * hq + 2);
                                a0 += c01.x * s.x - c01.y * s.y; a1 += c01.z * s.x - c01.w * s.y; a2 += c23.x * s.x - c23.y * s.y; a3 += c23.z * s.x - c23.w * s.y; }
                            LDS_FENCE();
                            const int st = sc * 16 + tl16, tl = d ? 255 - st : st; const size_t row = rowc + tl;
                            float* yp = Y + row * 512 + gq * 16 + 4 * hq;
                            if (d == 0) { *(f32x4*)yp = (f32x4){a0, a1, a2, a3}; }
                            else { const f32x4 yf = *(const f32x4*)yp; const u32x2 uw = *(const u32x2*)(PS5 + row * 512 + gq * 16 + 4 * hq);
                                const float y0 = yf.x + a0 + dsk.x * pg8::bfl(uw.x), y1 = yf.y + a1 + dsk.y * pg8::bfh(uw.x), y2 = yf.z + a2 + dsk.z * pg8::bfl(uw.y), y3 = yf.w + a3 + dsk.w * pg8::bfh(uw.y);
                                u32x2 w; w.x = pk2(gelu_tanh(y0), gelu_tanh(y1)); w.y = pk2(gelu_tanh(y2), gelu_tanh(y3));
                                *(u32x2*)(Gb + row * 512 + gq * 16 + 4 * hq) = w; }
                        }
                    }
                }
                __syncthreads();
                { bf16* ts = (bf16*)lds + wave * (64 * 66); const bf16* YT = (const bf16*)(R + R_YT);
                  for (int it = gw; it < 8 * 256; it += NGW) { const int cb = it & 7, tb = it >> 3;
                      for (int cl = 0; cl < 64; ++cl) ts[cl * 66 + lane] = YT[(size_t)(cb * 64 + cl) * T_TOK + tb * 64 + lane];
                      LDS_FENCE();
                      for (int tl = 0; tl < 64; ++tl) MIXIN[(size_t)(tb * 64 + tl) * D + 512 + cb * 64 + lane] = ts[lane * 66 + tl];
                      LDS_FENCE(); } }
            } else if (op == OP_SOFTMAX) {
                const float* SC = (const float*)(R + R_SC); bf16* PR = (bf16*)(R + R_PROB);
                for (int it = gw; it < T_TOK * 4; it += NGW) {
                    const f32x4 s = *((const f32x4*)(SC + (size_t)it * 256) + lane);
                    const float m = wave_max(fmaxf(fmaxf(s.x, s.y), fmaxf(s.z, s.w)));
                    const float e0 = __expf(s.x - m), e1 = __expf(s.y - m), e2 = __expf(s.z - m), e3 = __expf(s.w - m);
                    const float inv = 1.f / wave_sum((e0 + e1) + (e2 + e3));
                    u32x2 w; w.x = pk2(e0 * inv, e1 * inv); w.y = pk2(e2 * inv, e3 * inv);
                    *((u32x2*)(PR + (size_t)it * 256) + lane) = w;
                }
            } else if (op == OP_NORM_MIX || op == OP_NORM_XA || op == OP_NORM_MLP) {
                const float* gpost = (op == OP_NORM_MIX) ? INP(2) + (size_t)(layer * 2 + 1) * D : (op == OP_NORM_XA) ? INP(3) + (size_t)(layer * 2 + 1) * D : INP(5) + (size_t)(layer * 2 + 1) * D;
                const float* gpre = (op == OP_NORM_MIX) ? INP(3) + (size_t)(layer * 2) * D : (op == OP_NORM_XA) ? INP(5) + (size_t)(layer * 2) * D : INP(2) + (size_t)((layer + 1) * 2) * D;
                const bool want_hn = !(op == OP_NORM_MLP && layer == 3);
                for (int m = gw; m < T_TOK; m += NGW) norm_row(X + (size_t)m * D, X + (size_t)m * D, MIXOUT + (size_t)m * D, gpost, gpre, want_hn ? HN + (size_t)m * D : nullptr, lane);
            } else { continue; }
            GRID_SYNC();
        }
    }
}

extern "C" void kernel_launch(void* const* d_in, const int* in_sizes, int n_in, void* d_out, int out_size, void* d_ws, size_t ws_size, hipStream_t stream) {
    static int grid = 0;
    if (grid == 0) {
        if (n_in != 37 || out_size != T_TOK * D || ws_size < WS_END) { fprintf(stderr, "kernel_launch: unexpected shapes (n_in %d out %d ws %zu, need ws >= %zu)\n", n_in, out_size, ws_size, (size_t)WS_END); grid = -1; return; }
        int dev = 0, cus = 0, per_cu = 0;
        (void)hipGetDevice(&dev);
        (void)hipDeviceGetAttribute(&cus, hipDeviceAttributeMultiprocessorCount, dev);
        (void)hipFuncSetAttribute((const void*)fwd_kernel, hipFuncAttributeMaxDynamicSharedMemorySize, LDS_BYTES);
        (void)hipOccupancyMaxActiveBlocksPerMultiprocessor(&per_cu, (const void*)fwd_kernel, 512, LDS_BYTES);
        (void)hipGetLastError();
        grid = cus > 0 ? cus : 256;
        fprintf(stderr, "kernel_launch: grid %d (per_cu %d) ws %zu\n", grid, per_cu, ws_size);
    }
    if (grid < 0) return;
    Args a{};
    for (int i = 0; i < 37; ++i) a.in[i] = (const float*)d_in[i];
    a.out = (float*)d_out; a.ws = (unsigned char*)d_ws;
    void* kargs[] = {&a};
    hipError_t e = hipLaunchCooperativeKernel((void*)fwd_kernel, dim3(grid), dim3(512), kargs, LDS_BYTES, stream);
    if (e != hipSuccess) fprintf(stderr, "kernel_launch: cooperative launch failed: %s\n", hipGetErrorString(e));
}
```

```cpp
#include <hip/hip_runtime.h>
#include <hip/hip_cooperative_groups.h>
#include <cstdio>
#include <cstdint>
namespace cg = cooperative_groups;

namespace pg8 {
#define PG8_LAS __attribute__((address_space(3)))
typedef unsigned short bf16_t;
typedef short bf16x8 __attribute__((ext_vector_type(8)));
typedef float f32x4 __attribute__((ext_vector_type(4)));
typedef unsigned u32x4 __attribute__((ext_vector_type(4)));
constexpr int BM = 256, BK = 64, HALF = 128, HTB = HALF * BK * 2  , STAGE_BYTES = 8 * HTB, NXCD = 8, WGM = 8;

__host__ __device__ __forceinline__ int lds_byte(int r, int c) { const int st = (r >> 4) * 2 + (c >> 5), rr = r & 15, cc = c & 31, ob = rr * 64 + cc * 2; return st * 1024 + (ob ^ (((ob >> 9) & 1) << 5)); }
__host__ __device__ __forceinline__ void stage_rc(int b, int& R, int& C) { const int st = b / 1024, sb = b % 1024, swz = sb ^ (((sb >> 9) & 1) << 5); R = (st >> 1) * 16 + swz / 64; C = (st & 1) * 32 + (swz % 64) / 2; }
__host__ __device__ __forceinline__ int perm32(int rho) { const int n = rho >> 4, i = rho & 15; return 8 * (i >> 2) + 4 * n + (i & 3); }

struct Unit { int pm, pn; const char* a; const char* b; };
struct Gemm { int K, lda, ldb; };

struct Sched {
    int nM, nN, nwg, G, c; const char* A; const char* Bt; size_t sa_m, sa_n, sb_n, sb_b;
    __device__ __forceinline__ bool next(int i, Unit& u) const {
        const long L = (long)i * G + c; if (L >= nwg) return false;
        int wgid = (int)L; { const int q = nwg / NXCD, r = nwg % NXCD, xcd = wgid % NXCD, off = wgid / NXCD; wgid = (xcd < r ? xcd * (q + 1) : r * (q + 1) + (xcd - r) * q) + off; }
        const int nig = WGM * nN, gid = wgid / nig, fm = gid * WGM, gsz = (nM - fm) < WGM ? (nM - fm) : WGM;
        u.pm = fm + ((wgid % nig) % gsz); u.pn = (wgid % nig) / gsz;
        u.a = A + (size_t)u.pm * sa_m + (size_t)u.pn * sa_n; u.b = Bt + (size_t)u.pn * sb_n + (size_t)(u.pm >> 5) * sb_b; return true;
    }
    __device__ __forceinline__ void a_ready(const Unit&) const {}
    __device__ __forceinline__ void done(const Unit&) const {}
};

__device__ __forceinline__ unsigned cvt_pk_bf16(float lo, float hi) { unsigned r; asm volatile("v_cvt_pk_bf16_f32 %0, %1, %2" : "=v"(r) : "v"(lo), "v"(hi)); return r; }
__device__ __forceinline__ float bfl(unsigned w) { return __uint_as_float(w << 16); }
__device__ __forceinline__ float bfh(unsigned w) { return __uint_as_float(w & 0xffff0000u); }

enum { EP_BF16 = 0, EP_RELU2 = 1, EP_F32S = 2, EP_ODDIN = 3, EP_VT = 4, EP_GLU = 5 };
struct EpiRT {
    static constexpr bool PERM = true, AFTER_DRAIN = false;
    int mode; void* O; void* O2; const void* aux; int ldc; float scale;
    __device__ __forceinline__ void operator()(const f32x4 (&acc)[2][2][4][2], const Unit& u, int wr, int wc, int fr, int fq) const {
#pragma unroll
        for (int ai = 0; ai < 2; ++ai)
#pragma unroll
            for (int m = 0; m < 4; ++m) {
                const int row = u.pm * BM + ai * HALF + wr * 64 + m * 16 + fr;
#pragma unroll
                for (int bj = 0; bj < 2; ++bj) {
                    const int col = u.pn * BM + bj * HALF + wc * 32 + 8 * fq;
                    f32x4 v0 = acc[ai][bj][m][0], v1 = acc[ai][bj][m][1];
                    if (mode == EP_BF16) {
                        u32x4 w; w.x = cvt_pk_bf16(v0[0], v0[1]); w.y = cvt_pk_bf16(v0[2], v0[3]); w.z = cvt_pk_bf16(v1[0], v1[1]); w.w = cvt_pk_bf16(v1[2], v1[3]);
                        *(u32x4*)((bf16_t*)O + (size_t)row * ldc + col) = w;
                    } else if (mode == EP_RELU2) {
#pragma unroll
                        for (int e = 0; e < 4; ++e) { float a = fmaxf(v0[e], 0.f), b = fmaxf(v1[e], 0.f); v0[e] = a * a; v1[e] = b * b; }
                        u32x4 w; w.x = cvt_pk_bf16(v0[0], v0[1]); w.y = cvt_pk_bf16(v0[2], v0[3]); w.z = cvt_pk_bf16(v1[0], v1[1]); w.w = cvt_pk_bf16(v1[2], v1[3]);
                        *(u32x4*)((bf16_t*)O + (size_t)row * ldc + col) = w;
                    } else if (mode == EP_F32S) {
                        float* o = (float*)O + (size_t)row * ldc + col;
                        *(f32x4*)o = v0 * scale; *(f32x4*)(o + 4) = v1 * scale;
                    } else if (mode == EP_ODDIN) {
                        if (col < 512) {
                            u32x4 w; w.x = cvt_pk_bf16(v0[0], v0[1]); w.y = cvt_pk_bf16(v0[2], v0[3]); w.z = cvt_pk_bf16(v1[0], v1[1]); w.w = cvt_pk_bf16(v1[2], v1[3]);
                            *(u32x4*)((bf16_t*)O + (size_t)row * 512 + col) = w;
                        } else {
                            bf16_t* pt = (bf16_t*)O2 + (size_t)(col - 512) * 16384 + row;
#pragma unroll
                            for (int e = 0; e < 4; ++e) { pt[(size_t)e * 16384] = (bf16_t)(cvt_pk_bf16(v0[e], 0.f) & 0xffffu); pt[(size_t)(e + 4) * 16384] = (bf16_t)(cvt_pk_bf16(v1[e], 0.f) & 0xffffu); }
                        }
                    } else if (mode == EP_VT) {
                        bf16_t* vt = (bf16_t*)O + ((size_t)(row >> 8) * 1024 + col) * 256 + (row & 255);
#pragma unroll
                        for (int e = 0; e < 4; ++e) { vt[(size_t)e * 256] = (bf16_t)(cvt_pk_bf16(v0[e], 0.f) & 0xffffu); vt[(size_t)(e + 4) * 256] = (bf16_t)(cvt_pk_bf16(v1[e], 0.f) & 0xffffu); }
                    } else {
                        const u32x4 gw = *(const u32x4*)((const bf16_t*)aux + (size_t)row * 512 + col);
                        float g[8] = {bfl(gw.x), bfh(gw.x), bfl(gw.y), bfh(gw.y), bfl(gw.z), bfh(gw.z), bfl(gw.w), bfh(gw.w)};
                        float o[8];
#pragma unroll
                        for (int e = 0; e < 4; ++e) { o[e] = g[e] / (1.f + __expf(-v0[e])); o[e + 4] = g[e + 4] / (1.f + __expf(-v1[e])); }
                        u32x4 w; w.x = cvt_pk_bf16(o[0], o[1]); w.y = cvt_pk_bf16(o[2], o[3]); w.z = cvt_pk_bf16(o[4], o[5]); w.w = cvt_pk_bf16(o[6], o[7]);
                        *(u32x4*)((bf16_t*)O + (size_t)row * ldc + col) = w;
                    }
                }
            }
    }
};
template <class Epi, class Sched, bool ALIGN_EPI = false, bool SP2 = false>
__device__ __forceinline__ void gemm_phase(PG8_LAS unsigned char* lds, const Gemm g, const Sched& S, const Epi& E, const int tid) {
    const int wid = __builtin_amdgcn_readfirstlane(tid >> 6), lane = tid & 63, wr = wid >> 2, wc = wid & 3, fr = lane & 15, fq = lane >> 4;
    const int K = g.K, nt = K / BK;
    unsigned voffA[2], voffB[2];
#pragma unroll
    for (int i = 0; i < 2; ++i) { int R, C; stage_rc(tid * 16 + i * 8192, R, C); const int Rb = Epi::PERM ? ((R & ~31) + perm32(R & 31)) : R;
        voffA[i] = (unsigned)(R * g.lda + C) * 2u; voffB[i] = (unsigned)(Rb * g.ldb + C) * 2u; }
    const size_t kstep = (size_t)(BK * 2);
    const size_t hstepA = (size_t)HALF * g.lda * 2, hstepB = (size_t)HALF * g.ldb * 2;
    const unsigned ldsw = (unsigned)wid * 1024u;
    const int aoff = lds_byte(wr * 64 + fr, fq * 8), boff = lds_byte(wc * 32 + fr, fq * 8);
#define PG8_SA(b, h) (((b) * 2 + (h)) * HTB)
#define PG8_SB(b, h) ((4 + (b) * 2 + (h)) * HTB)
#define PG8_STAGE(bufoff, gbase, voff) do { _Pragma("unroll") for (int _i = 0; _i < 2; ++_i) \
        __builtin_amdgcn_global_load_lds((const unsigned*)((const char*)(gbase) + (voff)[_i]), (PG8_LAS unsigned*)(lds + (bufoff) + ldsw + _i * 8192), 16, 0, 0); } while (0)
#define PG8_LDA(dst, b, h) do { _Pragma("unroll") for (int m = 0; m < 4; ++m) _Pragma("unroll") for (int k = 0; k < 2; ++k) dst[m][k] = *(const PG8_LAS bf16x8*)(lds + PG8_SA(b, h) + aoff + m * 2048 + k * 1024); } while (0)
#define PG8_LDB(dst, b, h) do { _Pragma("unroll") for (int n = 0; n < 2; ++n) _Pragma("unroll") for (int k = 0; k < 2; ++k) dst[n][k] = *(const PG8_LAS bf16x8*)(lds + PG8_SB(b, h) + boff + n * 2048 + k * 1024); } while (0)
#define PG8_MMA(ai, bj, At, Bt) do { __builtin_amdgcn_s_setprio(1); _Pragma("unroll") for (int m = 0; m < 4; ++m) _Pragma("unroll") for (int n = 0; n < 2; ++n) _Pragma("unroll") for (int k = 0; k < 2; ++k) \
        acc[ai][bj][m][n] = __builtin_amdgcn_mfma_f32_16x16x32_bf16(Bt[n][k], At[m][k], acc[ai][bj][m][n], 0, 0, 0); __builtin_amdgcn_s_setprio(0); } while (0)
#define PG8_WAIT_V(n) asm volatile("s_waitcnt vmcnt(" #n ")" ::: "memory")
#define PG8_WAIT_L(n) asm volatile("s_waitcnt lgkmcnt(" #n ")" ::: "memory")
#define PG8_BAR __builtin_amdgcn_s_barrier()
#define PG8_SCHED __builtin_amdgcn_sched_barrier(0)
    Unit cur, nxt; int ui = 0;
    if (!S.next(0, cur)) return;
    f32x4 acc[2][2][4][2];
#pragma unroll
    for (int a = 0; a < 2; ++a)
#pragma unroll
        for (int b = 0; b < 2; ++b)
#pragma unroll
            for (int m = 0; m < 4; ++m)
#pragma unroll
                for (int n = 0; n < 2; ++n) acc[a][b][m][n] = (f32x4){0.f, 0.f, 0.f, 0.f};
    bf16x8 At[4][2], B0[2][2], B1[2][2];
    const char* cA = cur.a; const char* cB = cur.b;
    S.a_ready(cur);
    if constexpr (SP2) {
        PG8_STAGE(PG8_SB(0, 0), cB, voffB); PG8_STAGE(PG8_SB(0, 1), cB + hstepB, voffB); PG8_STAGE(PG8_SA(0, 0), cA, voffA); PG8_STAGE(PG8_SA(0, 1), cA + hstepA, voffA);
        if (wr == 1) PG8_BAR;
        PG8_WAIT_V(2); PG8_BAR;
        PG8_STAGE(PG8_SB(1, 0), cB + kstep, voffB); PG8_STAGE(PG8_SA(1, 0), cA + kstep, voffA); PG8_STAGE(PG8_SB(1, 1), cB + hstepB + kstep, voffB);
        PG8_WAIT_V(6); PG8_BAR;
    } else {
        PG8_STAGE(PG8_SB(0, 0), cB, voffB); PG8_STAGE(PG8_SA(0, 0), cA, voffA); PG8_STAGE(PG8_SB(0, 1), cB + hstepB, voffB); PG8_STAGE(PG8_SA(0, 1), cA + hstepA, voffA);
        if (wr == 1) PG8_BAR;
        PG8_WAIT_V(4); PG8_BAR;
        PG8_STAGE(PG8_SB(1, 0), cB + kstep, voffB); PG8_STAGE(PG8_SA(1, 0), cA + kstep, voffA); PG8_STAGE(PG8_SB(1, 1), cB + hstepB + kstep, voffB);
        PG8_WAIT_V(6); PG8_BAR;
    }
    for (;;) {
        const bool has_next = S.next(ui + 1, nxt);
        const char* nA = has_next ? nxt.a : cA; const char* nB = has_next ? nxt.b : cB;
        for (int t = 0; t < nt; t += 2) {
            const bool last = (t == nt - 2);
            const char* a1 = cA + (size_t)(t + 1) * kstep;
            const char* a2 = last ? nA : cA + (size_t)(t + 2) * kstep; const char* b2 = last ? nB : cB + (size_t)(t + 2) * kstep;
            const char* a3 = a2 + kstep; const char* b3 = b2 + kstep;
            if (last && has_next) S.a_ready(nxt);
            if constexpr (SP2) {
            PG8_LDB(B0, 0, 0); PG8_LDB(B1, 0, 1); PG8_SCHED; PG8_LDA(At, 0, 0); PG8_STAGE(PG8_SA(1, 1), a1 + hstepA, voffA);
            PG8_WAIT_V(8); PG8_WAIT_L(0); PG8_BAR; PG8_MMA(0, 0, At, B0); PG8_MMA(0, 1, At, B1); PG8_BAR; PG8_SCHED;
            PG8_LDA(At, 0, 1); PG8_STAGE(PG8_SB(0, 0), b2, voffB); PG8_STAGE(PG8_SB(0, 1), b2 + hstepB, voffB); PG8_STAGE(PG8_SA(0, 0), a2, voffA);
            PG8_WAIT_V(8); PG8_WAIT_L(0); PG8_BAR; PG8_MMA(1, 0, At, B0); PG8_MMA(1, 1, At, B1); PG8_BAR; PG8_SCHED;
            PG8_LDB(B0, 1, 0); PG8_LDB(B1, 1, 1); PG8_SCHED; PG8_LDA(At, 1, 0); PG8_STAGE(PG8_SA(0, 1), a2 + hstepA, voffA);
            PG8_WAIT_V(8); PG8_WAIT_L(0); PG8_BAR; PG8_MMA(0, 0, At, B0); PG8_MMA(0, 1, At, B1); PG8_BAR; PG8_SCHED;
            PG8_LDA(At, 1, 1); PG8_STAGE(PG8_SB(1, 0), b3, voffB); PG8_STAGE(PG8_SB(1, 1), b3 + hstepB, voffB); PG8_STAGE(PG8_SA(1, 0), a3, voffA);
            PG8_WAIT_V(8); PG8_WAIT_L(0); PG8_BAR; PG8_MMA(1, 0, At, B0); PG8_MMA(1, 1, At, B1); PG8_BAR; PG8_SCHED;
            } else {
            PG8_LDB(B0, 0, 0); PG8_SCHED; PG8_LDA(At, 0, 0); PG8_STAGE(PG8_SA(1, 1), a1 + hstepA, voffA);
            PG8_WAIT_L(8); PG8_BAR; PG8_WAIT_L(0); PG8_MMA(0, 0, At, B0); PG8_BAR; PG8_SCHED;
            PG8_LDB(B1, 0, 1); PG8_STAGE(PG8_SB(0, 0), b2, voffB);
            PG8_BAR; PG8_WAIT_L(0); PG8_MMA(0, 1, At, B1); PG8_BAR;
            PG8_LDA(At, 0, 1); PG8_STAGE(PG8_SA(0, 0), a2, voffA);
            PG8_BAR; PG8_WAIT_L(0); PG8_MMA(1, 0, At, B0); PG8_BAR; PG8_SCHED;
            PG8_STAGE(PG8_SB(0, 1), b2 + hstepB, voffB);
            PG8_WAIT_V(6); PG8_BAR; PG8_MMA(1, 1, At, B1); PG8_BAR;
            PG8_LDB(B0, 1, 0); PG8_SCHED; PG8_LDA(At, 1, 0); PG8_STAGE(PG8_SA(0, 1), a2 + hstepA, voffA);
            PG8_WAIT_L(8); PG8_BAR; PG8_WAIT_L(0); PG8_MMA(0, 0, At, B0); PG8_BAR; PG8_SCHED;
            PG8_LDB(B1, 1, 1); PG8_STAGE(PG8_SB(1, 0), b3, voffB);
            PG8_BAR; PG8_WAIT_L(0); PG8_MMA(0, 1, At, B1); PG8_BAR;
            PG8_LDA(At, 1, 1); PG8_STAGE(PG8_SA(1, 0), a3, voffA);
            PG8_BAR; PG8_WAIT_L(0); PG8_MMA(1, 0, At, B0); PG8_BAR; PG8_SCHED;
            PG8_STAGE(PG8_SB(1, 1), b3 + hstepB, voffB);
            PG8_WAIT_V(6); PG8_BAR; PG8_MMA(1, 1, At, B1); PG8_BAR;
            }
        }
        if constexpr (ALIGN_EPI) { if (wr == 0) PG8_BAR; }
        if constexpr (!Epi::AFTER_DRAIN) { E(acc, cur, wr, wc, fr, fq); S.done(cur); }
        if (!has_next) break;
#pragma unroll
        for (int a = 0; a < 2; ++a)
#pragma unroll
            for (int b = 0; b < 2; ++b)
#pragma unroll
                for (int m = 0; m < 4; ++m)
#pragma unroll
                    for (int n = 0; n < 2; ++n) acc[a][b][m][n] = (f32x4){0.f, 0.f, 0.f, 0.f};
        cur = nxt; cA = nA; cB = nB; ++ui;
        if constexpr (ALIGN_EPI) { if (wr == 1) PG8_BAR; }
    }
    PG8_WAIT_V(0);
    if constexpr (!ALIGN_EPI) { if (wr == 0) PG8_BAR; }
    PG8_BAR;
    if constexpr (Epi::AFTER_DRAIN) { E.fused(acc, cur, wr, wc, fr, fq, lds, wid, lane); S.done(cur); }
#undef PG8_SA
#undef PG8_SB
#undef PG8_STAGE
#undef PG8_LDA
#undef PG8_LDB
#undef PG8_MMA
#undef PG8_WAIT_V
#undef PG8_WAIT_L
#undef PG8_BAR
#undef PG8_SCHED
}
}

typedef unsigned short bf16;
typedef float f32x4 __attribute__((ext_vector_type(4)));
typedef unsigned u32x4 __attribute__((ext_vector_type(4)));
typedef unsigned u32x2 __attribute__((ext_vector_type(2)));
constexpr int L_SEQ = 8192, T_TOK = 16384, D = 1024, FF = 4096, NMEMT = 512;
constexpr int NFFT = 16384;
constexpr float RMS_EPS = 1e-6f;
constexpr int LDS_BYTES = 147456;
constexpr size_t MiB = 1u << 20;
constexpr size_t WS_NORMS = 0;
constexpr size_t WS_KT0B = 8192;
constexpr size_t WS_BAR = 16384, WS_BAR_BYTES = 16384;
constexpr size_t WS_TW = 65536;
constexpr size_t WS_S5F = 1 * MiB;
constexpr size_t WS_H2 = 4 * MiB;
constexpr size_t WS_MN = 6 * MiB;
constexpr size_t WS_KB = 7 * MiB;
constexpr size_t WS_VT = 8 * MiB;
constexpr size_t WS_PART = 9 * MiB;
constexpr size_t WS_W = 16 * MiB;
constexpr size_t W_IN = 0, W_OUT = 4 * MiB, W_Q = 6 * MiB, W_K = 8 * MiB, W_V = 10 * MiB, W_O = 12 * MiB, W_1 = 14 * MiB, W_2 = 22 * MiB, W_GLU = 30 * MiB;
constexpr size_t WS_HN = 48 * MiB;
constexpr size_t WS_MIXOUT = 80 * MiB;
constexpr size_t WS_MIXIN = 112 * MiB;
constexpr size_t WS_R = 144 * MiB;
constexpr size_t R_P = 0;
constexpr size_t R_Q = 0, R_SC = 32 * MiB, R_PROB = 96 * MiB;
constexpr size_t R_H = 0;
constexpr size_t R_SPEC = 0, R_KT = 64 * MiB, R_PT = 64 * MiB, R_Y = 64 * MiB, R_PS5 = 112 * MiB, R_G = 128 * MiB, R_YT = 144 * MiB;
constexpr size_t WS_END = WS_R + 160 * MiB;

struct Args { const float* in[37]; float* out; unsigned char* ws; };
constexpr int TAB_OFF = LDS_BYTES - 512;
__device__ __forceinline__ const void* ldptr(const unsigned char* lds, int i) {
    const volatile unsigned* p = (const volatile unsigned*)(lds + TAB_OFF) + 2 * i;
    const unsigned lo = __builtin_amdgcn_readfirstlane(p[0]), hi = __builtin_amdgcn_readfirstlane(p[1]);
    return (const void*)(((unsigned long long)hi << 32) | lo);
}

__device__ __forceinline__ float bf2f(bf16 v) { return __uint_as_float((unsigned)v << 16); }
__device__ __forceinline__ unsigned f2bf(float f) { unsigned u = __float_as_uint(f); return (u + 0x7fffu + ((u >> 16) & 1u)) >> 16; }
__device__ __forceinline__ unsigned pk2(float lo, float hi) { return f2bf(lo) | (f2bf(hi) << 16); }
__device__ __forceinline__ float wave_sum(float v) {
#pragma unroll
    for (int o = 1; o < 64; o <<= 1) v += __shfl_xor(v, o);
    return v;
}
__device__ __forceinline__ float wave_max(float v) {
#pragma unroll
    for (int o = 1; o < 64; o <<= 1) v = fmaxf(v, __shfl_xor(v, o));
    return v;
}
#define XB_TMO      128
#define XB_XCNT(j)  (256  + 64 * (j))
#define XB_XSUB(j)  (1280 + 64 * (j))
#define XB_XGEN(j)  (2304 + 64 * (j))
#define XB_TOP      3328
#define XB_TOPGEN   3392
#define XCD_BAR_WORDS 3456
#define XB_SPIN_CAP (1u << 18)

__device__ __forceinline__ unsigned xb_ld(unsigned* p)              { return __hip_atomic_load(p, __ATOMIC_RELAXED, __HIP_MEMORY_SCOPE_AGENT); }
__device__ __forceinline__ unsigned xb_add(unsigned* p, unsigned v) { return __hip_atomic_fetch_add(p, v, __ATOMIC_RELAXED, __HIP_MEMORY_SCOPE_AGENT); }
__device__ __forceinline__ unsigned xb_xcc_id() { return (unsigned)__builtin_amdgcn_s_getreg((3 << 11) | 20) & 0xFu; }
#define XB_SPIN(cond, bar) do { unsigned _sp = 0; while (cond) { __builtin_amdgcn_s_sleep(1); \
    if ((++_sp & 255u) == 0u) { if (xb_ld(&(bar)[XB_TMO])) break; if (_sp > XB_SPIN_CAP) { atomicAdd(&(bar)[XB_TMO], 1u); break; } } } } while (0)

struct XcdBarrier {
    unsigned* bar; unsigned x;
    volatile __attribute__((address_space(3))) unsigned* st;
};

__device__ __forceinline__ XcdBarrier xcd_barrier_post(unsigned* bar, volatile __attribute__((address_space(3))) unsigned* st) {
    XcdBarrier b; b.bar = bar; b.x = xb_xcc_id(); b.st = st;
    if (threadIdx.x == 0) (void)xb_add(&bar[XB_XCNT(b.x)], 1u);
    return b;
}
__device__ __forceinline__ void xcd_barrier_complete(unsigned* bar, unsigned x, unsigned& nloc, unsigned& nx) {
    const unsigned G = gridDim.x * gridDim.y * gridDim.z;
    unsigned sum, cnt, mine, sp = 0u;
    for (;;) {
        sum = 0u; cnt = 0u; mine = 0u;
#pragma unroll
        for (unsigned j = 0; j < 16; ++j) { const unsigned c = xb_ld(&bar[XB_XCNT(j)]); sum += c; cnt += (c > 0u) ? 1u : 0u; mine = (j == x) ? c : mine; }
        if (sum == G) break;
        __builtin_amdgcn_s_sleep(1);
        if ((++sp & 255u) == 0u) { if (xb_ld(&bar[XB_TMO])) break; if (sp > XB_SPIN_CAP) { atomicAdd(&bar[XB_TMO], 1u); break; } }
    }
    nloc = mine > 0u ? mine : 1u; nx = cnt > 0u ? cnt : 1u;
}

__device__ __forceinline__ void xcd_barrier(const XcdBarrier& b) {
    asm volatile("s_waitcnt vmcnt(0)" ::: "memory");
    __syncthreads();
    if (threadIdx.x == 0) {
        unsigned* bar = b.bar;
        __builtin_amdgcn_s_waitcnt(0);
        unsigned nloc = b.st[0], nx = b.st[1];
        if (nloc == 0u) { xcd_barrier_complete(bar, b.x, nloc, nx); b.st[0] = nloc; b.st[1] = nx; }
        const unsigned old = xb_add(&bar[XB_XSUB(b.x)], 1u);
        const unsigned gen = old / nloc;
        if (old + 1u == (gen + 1u) * nloc) {
            __builtin_amdgcn_fence(__ATOMIC_RELEASE, "agent");
            asm volatile("s_waitcnt vmcnt(0)" ::: "memory");
            const unsigned og = xb_add(&bar[XB_TOP], 1u);
            const unsigned tg = og / nx;
            if (og + 1u == (tg + 1u) * nx) xb_add(&bar[XB_TOPGEN], 1u);
            else XB_SPIN(xb_ld(&bar[XB_TOPGEN]) == tg, bar);
            __builtin_amdgcn_fence(__ATOMIC_ACQUIRE, "agent");
            xb_add(&bar[XB_XGEN(b.x)], 1u);
            asm volatile("s_waitcnt vmcnt(0)" ::: "memory");
        } else {
            XB_SPIN(xb_ld(&bar[XB_XGEN(b.x)]) == gen, bar);
            __builtin_amdgcn_fence(__ATOMIC_ACQUIRE, "agent");
            asm volatile("s_waitcnt vmcnt(0)" ::: "memory");
        }
    }
    __syncthreads();
}

#define LDS_FENCE() asm volatile("s_waitcnt lgkmcnt(0)" ::: "memory")

__device__ __forceinline__ void transpose_item(const float* W, int ldw, int ncols, bf16* WT, int ldt, float* scr, int item, int lane) {
    const int nblk = ncols / 32, kb = item / nblk, nb = item % nblk, k0 = 64 * kb, n0 = 32 * nb;
#pragma unroll 8
    for (int i = 0; i < 32; ++i) { const int kk = 2 * i + (lane >> 5); scr[kk * 33 + (lane & 31)] = W[(size_t)(k0 + kk) * ldw + n0 + (lane & 31)]; }
    LDS_FENCE();
    const int c = lane & 7;
#pragma unroll
    for (int j = 0; j < 4; ++j) { const int n = (lane >> 3) + 8 * j; const float* s = scr + (8 * c) * 33 + n;
        u32x4 o; o.x = pk2(s[0 * 33], s[1 * 33]); o.y = pk2(s[2 * 33], s[3 * 33]); o.z = pk2(s[4 * 33], s[5 * 33]); o.w = pk2(s[6 * 33], s[7 * 33]);
        *(u32x4*)(WT + (size_t)(n0 + n) * ldt + k0 + 8 * c) = o; }
    LDS_FENCE();
}

__device__ __forceinline__ void norm_row(const float* xin, float* xout, const bf16* br, const float* gpost, const float* gpre, bf16* hn, int lane) {
    f32x4 v[4];
#pragma unroll
    for (int j = 0; j < 4; ++j) v[j] = *((const f32x4*)xin + lane + 64 * j);
    if (br) {
        f32x4 r[4]; float ss = 0.f;
#pragma unroll
        for (int j = 0; j < 4; ++j) { const u32x2 w = *((const u32x2*)br + lane + 64 * j);
            r[j] = (f32x4){pg8::bfl(w.x), pg8::bfh(w.x), pg8::bfl(w.y), pg8::bfh(w.y)}; ss += (r[j].x * r[j].x + r[j].y * r[j].y) + (r[j].z * r[j].z + r[j].w * r[j].w); }
        const float rstd = rsqrtf(wave_sum(ss) * (1.f / D) + RMS_EPS);
#pragma unroll
        for (int j = 0; j < 4; ++j) { const f32x4 g = *((const f32x4*)gpost + lane + 64 * j); v[j] = v[j] + r[j] * rstd * g; }
    }
    if (xout) {
#pragma unroll
        for (int j = 0; j < 4; ++j) *((f32x4*)xout + lane + 64 * j) = v[j];
    }
    if (hn) {
        float ss = 0.f;
#pragma unroll
        for (int j = 0; j < 4; ++j) ss += (v[j].x * v[j].x + v[j].y * v[j].y) + (v[j].z * v[j].z + v[j].w * v[j].w);
        const float rstd = rsqrtf(wave_sum(ss) * (1.f / D) + RMS_EPS);
#pragma unroll
        for (int j = 0; j < 4; ++j) { const f32x4 g = *((const f32x4*)gpre + lane + 64 * j); const f32x4 o = v[j] * rstd * g;
            u32x2 w; w.x = pk2(o.x, o.y); w.y = pk2(o.z, o.w); *((u32x2*)hn + lane + 64 * j) = w; }
    }
}

__device__ __forceinline__ void fft_fwd(float2* x, const float2* __restrict__ TW, int tid) {
    for (int ls = 13; ls >= 0; --ls) {
        const int s = 1 << ls;
#pragma unroll 4
        for (int j = tid; j < 8192; j += 512) {
            const int off = j & (s - 1), i = ((j >> ls) << (ls + 1)) + off;
            const float2 a = x[i], b = x[i + s], w = TW[off << (13 - ls)];
            const float dx = a.x - b.x, dy = a.y - b.y;
            x[i] = make_float2(a.x + b.x, a.y + b.y);
            x[i + s] = make_float2(dx * w.x - dy * w.y, dx * w.y + dy * w.x);
        }
        __syncthreads();
    }
}
__device__ __forceinline__ void fft_inv(float2* x, const float2* __restrict__ TW, int tid) {
    for (int ls = 0; ls <= 13; ++ls) {
        const int s = 1 << ls;
#pragma unroll 4
        for (int j = tid; j < 8192; j += 512) {
            const int off = j & (s - 1), i = ((j >> ls) << (ls + 1)) + off;
            const float2 a = x[i], b = x[i + s], w = TW[off << (13 - ls)];
            const float bx = b.x * w.x + b.y * w.y, by = b.y * w.x - b.x * w.y;
            x[i] = make_float2(a.x + bx, a.y + by);
            x[i + s] = make_float2(a.x - bx, a.y - by);
        }
        __syncthreads();
    }
}
__device__ __forceinline__ void spec_mul(float2* x, const unsigned* __restrict__ sp, int tid) {
    for (int p = tid; p < NFFT; p += 512) { const unsigned w = sp[p]; const float kr = pg8::bfl(w), ki = pg8::bfh(w); const float2 a = x[p]; x[p] = make_float2(a.x * kr - a.y * ki, a.x * ki + a.y * kr); }
    __syncthreads();
}
__device__ __forceinline__ float hy_sc(const bf16* r, int t, float w0, float w1, float w2, float sb) {
    float v = w1 * bf2f(r[t]) + sb;
    if (t > 0) v += w0 * bf2f(r[t - 1]);
    if (t < L_SEQ - 1) v += w2 * bf2f(r[t + 1]);
    return v;
}
__device__ __forceinline__ float gelu_tanh(float x) { const float u = 0.7978845608028654f * (x + 0.044715f * x * x * x); return 0.5f * x * (1.f + tanhf(u)); }

enum { OP_CONVERT = 0, OP_F2, OP_F3, OP_GEMM_K, OP_GEMM_V, OP_GEMM_IN, OP_MIX1, OP_MIX2, OP_GEMM_GLU, OP_GEMM_OUT, OP_NORM_MIX, OP_GEMM_Q, OP_GEMM_S, OP_SOFTMAX, OP_GEMM_PV,
       OP_GEMM_O, OP_NORM_XA, OP_GEMM_UP, OP_GEMM_DOWN, OP_NORM_MLP, OP_COUNT };

__global__ void __launch_bounds__(512, 2) fwd_kernel(Args args) {
    extern __shared__ __attribute__((aligned(16))) unsigned char lds[];
    cg::grid_group grid = cg::this_grid();
#define GRID_SYNC() do { xcd_barrier(xbar); } while (0)
    { const int tid = threadIdx.x;
    if (tid < 37) ((unsigned long long*)(lds + TAB_OFF))[tid] = (unsigned long long)args.in[tid];
    if (tid == 37) ((unsigned long long*)(lds + TAB_OFF))[37] = (unsigned long long)args.out;
    if (tid == 38) ((unsigned long long*)(lds + TAB_OFF))[38] = (unsigned long long)args.ws;
      if (tid == 40 || tid == 41) ((unsigned*)(lds + TAB_OFF + 384))[tid - 40] = 0u; }
    __syncthreads();
    XcdBarrier xbar = xcd_barrier_post((unsigned*)(args.ws + WS_BAR), (volatile __attribute__((address_space(3))) unsigned*)(lds + TAB_OFF + 384));
    asm volatile("s_waitcnt vmcnt(0) lgkmcnt(0)" ::: "memory"); __syncthreads(); grid.sync();
#define INP(i) ((const float*)ldptr(lds, (i)))
    for (int layer_ = 0; layer_ < 4; ++layer_) {
#ifndef REPEAT_MASK
#define REPEAT_MASK 0u
#endif
        for (int opi = 0; opi < OP_COUNT * 2; ++opi) {
            const int op = opi >> 1;
            if ((opi & 1) && !((REPEAT_MASK >> op) & 1u)) continue;
            int tid = threadIdx.x; asm volatile("" : "+v"(tid));
            int bid = blockIdx.x; asm volatile("" : "+s"(bid));
            int G = gridDim.x; asm volatile("" : "+s"(G));
            int layer = layer_; asm volatile("" : "+s"(layer));
            const int lane = tid & 63, wave = __builtin_amdgcn_readfirstlane(tid >> 6);
            const int gw = bid * 8 + wave, NGW = G * 8, gt = bid * 512 + tid, GT = G * 512;
            const int jj = layer >> 1; const bool odd = (layer & 1) != 0;
            unsigned char* ws = (unsigned char*)ldptr(lds, 38);
            float* X = (float*)ldptr(lds, 37);
            float* KT0B = (float*)(ws + WS_KT0B); float2* TW = (float2*)(ws + WS_TW);
            float2* S5F = (float2*)(ws + WS_S5F); float* H2 = (float*)(ws + WS_H2);
            bf16* MN = (bf16*)(ws + WS_MN); bf16* KB = (bf16*)(ws + WS_KB); bf16* VT = (bf16*)(ws + WS_VT);
            unsigned char* WB = ws + WS_W;
            bf16* HN = (bf16*)(ws + WS_HN); bf16* MIXOUT = (bf16*)(ws + WS_MIXOUT); bf16* MIXIN = (bf16*)(ws + WS_MIXIN);
            unsigned char* R = ws + WS_R;

            bool do_sync = true;
            pg8::Gemm g{0, 0, 0}; pg8::Sched S{}; pg8::EpiRT E{}; bool is_gemm = false;
            S.G = G; S.c = bid; S.sa_n = 0; S.sb_b = 0;
            auto setg = [&](const void* A, int lda, const void* Bt, int ldb, int M, int N, int K) {
                g.K = K; g.lda = lda; g.ldb = ldb; S.nM = M / 256; S.nN = N / 256; S.nwg = S.nM * S.nN; S.A = (const char*)A; S.Bt = (const char*)Bt;
                S.sa_m = (size_t)256 * lda * 2; S.sb_n = (size_t)256 * ldb * 2; is_gemm = true; };
            switch (op) {
            case OP_GEMM_K: setg(MN, D, WB + W_K, D, NMEMT, D, D); E.mode = pg8::EP_BF16; E.O = KB; E.ldc = D; do_sync = false; break;
            case OP_GEMM_V: setg(MN, D, WB + W_V, D, NMEMT, D, D); E.mode = pg8::EP_VT; E.O = VT; do_sync = false; break;
            case OP_GEMM_IN: setg(HN, D, WB + W_IN, D, T_TOK, 2048, D);
                if (!odd) { E.mode = pg8::EP_BF16; E.O = R + R_P; E.ldc = 2048; } else { E.mode = pg8::EP_ODDIN; E.O = R + R_PS5; E.O2 = R + R_PT; } break;
            case OP_GEMM_GLU: if (odd) { setg(R + R_G, 512, WB + W_GLU, 512, T_TOK, 512, 512); E.mode = pg8::EP_GLU; E.O = MIXIN; E.ldc = D; E.aux = R + R_G; } break;
            case OP_GEMM_OUT: setg(MIXIN, D, WB + W_OUT, D, T_TOK, D, D); E.mode = pg8::EP_BF16; E.O = MIXOUT; E.ldc = D; break;
            case OP_GEMM_Q: setg(HN, D, WB + W_Q, D, T_TOK, D, D); E.mode = pg8::EP_BF16; E.O = R + R_Q; E.ldc = D; break;
            case OP_GEMM_S: setg(R + R_Q, D, KB, D, T_TOK, D, 256); S.sa_n = 512; S.sb_n = 512; S.sb_b = (size_t)256 * D * 2;
                E.mode = pg8::EP_F32S; E.O = R + R_SC; E.ldc = D; E.scale = 0.0625f; break;
            case OP_GEMM_PV: setg(R + R_PROB, D, VT, 256, T_TOK, D, 256); S.sa_n = 512; S.sb_n = (size_t)256 * 256 * 2; S.sb_b = (size_t)1024 * 256 * 2;
                E.mode = pg8::EP_BF16; E.O = R + R_Q; E.ldc = D; break;
            case OP_GEMM_O: setg(R + R_Q, D, WB + W_O, D, T_TOK, D, D); E.mode = pg8::EP_BF16; E.O = MIXOUT; E.ldc = D; break;
            case OP_GEMM_UP: setg(HN, D, WB + W_1, D, T_TOK, FF, D); E.mode = pg8::EP_RELU2; E.O = R + R_H; E.ldc = FF; break;
            case OP_GEMM_DOWN: setg(R + R_H, FF, WB + W_2, FF, T_TOK, D, FF); E.mode = pg8::EP_BF16; E.O = MIXOUT; E.ldc = D; break;
            default: break;
            }
            if (is_gemm) {
                pg8::gemm_phase<pg8::EpiRT, pg8::Sched, true, true>((PG8_LAS unsigned char*)lds, g, S, E, tid);
                __syncthreads();
                if (do_sync) GRID_SYNC();
                continue;
            }
            if (op == OP_CONVERT) {
                float* scr = (float*)(lds + wave * 16384);
                const float* Win = odd ? INP(17) + (size_t)jj * D * 2048 : INP(12) + (size_t)jj * D * 2048;
                const float* Wout = odd ? INP(36) + (size_t)jj * D * D : INP(16) + (size_t)jj * D * D;
                const int inc0 = odd ? 0 : 512;
                const int I_IN = (D / 64) * ((2048 - inc0) / 32), I_SQ = (D / 64) * (D / 32), I_1 = (D / 64) * (FF / 32), I_2 = (FF / 64) * (D / 32), I_GLU = odd ? (512 / 64) * (512 / 32) : 0;
                const int NIT = I_IN + 5 * I_SQ + I_1 + I_2 + I_GLU;
                for (int it = gw; it < NIT; it += NGW) {
                    int r = it;
                    if (r < I_IN) { transpose_item(Win + inc0, 2048, 2048 - inc0, (bf16*)(WB + W_IN) + (size_t)inc0 * D, D, scr, r, lane); continue; } r -= I_IN;
                    if (r < I_SQ) { transpose_item(Wout, D, D, (bf16*)(WB + W_OUT), D, scr, r, lane); continue; } r -= I_SQ;
                    if (r < I_SQ) { transpose_item(INP(6) + (size_t)layer * D * D, D, D, (bf16*)(WB + W_Q), D, scr, r, lane); continue; } r -= I_SQ;
                    if (r < I_SQ) { transpose_item(INP(7) + (size_t)layer * D * D, D, D, (bf16*)(WB + W_K), D, scr, r, lane); continue; } r -= I_SQ;
                    if (r < I_SQ) { transpose_item(INP(8) + (size_t)layer * D * D, D, D, (bf16*)(WB + W_V), D, scr, r, lane); continue; } r -= I_SQ;
                    if (r < I_SQ) { transpose_item(INP(9) + (size_t)layer * D * D, D, D, (bf16*)(WB + W_O), D, scr, r, lane); continue; } r -= I_SQ;
                    if (r < I_1) { transpose_item(INP(10) + (size_t)layer * D * FF, FF, FF, (bf16*)(WB + W_1), D, scr, r, lane); continue; } r -= I_1;
                    if (r < I_2) { transpose_item(INP(11) + (size_t)layer * FF * D, D, D, (bf16*)(WB + W_2), FF, scr, r, lane); continue; } r -= I_2;
                    transpose_item(INP(26) + (size_t)jj * 512 * 512, 512, 512, (bf16*)(WB + W_GLU), 512, scr, r, lane);
                }
                if (!odd) {
                    const float* Wg = INP(13) + (size_t)jj * 4 * 128 * 128; const float* psc = INP(14) + (size_t)jj * 512;
                    for (int o = gt; o < D * 512; o += GT) { const int k = o >> 9, n = o & 511, gq = n >> 7, d = n & 127;
                        const float* wr_ = Win + (size_t)k * 2048 + gq * 128; const float* wg = Wg + (size_t)gq * 128 * 128 + d; float acc = 0.f;
#pragma unroll 8
                        for (int c = 0; c < 128; ++c) acc += wr_[c] * wg[c * 128];
                        ((bf16*)(WB + W_IN))[(size_t)n * D + k] = (bf16)f2bf(acc * psc[n]); }
                }
                for (int m = gw; m < NMEMT; m += NGW) norm_row(INP(1) + (size_t)m * D, nullptr, nullptr, nullptr, INP(4) + (size_t)layer * D, MN + (size_t)m * D, lane);
                if (layer == 0) {
                    for (int m = gw; m < T_TOK; m += NGW) norm_row(INP(0) + (size_t)m * D, X + (size_t)m * D, nullptr, nullptr, INP(2), HN + (size_t)m * D, lane);
                    for (int k = gt; k < 8192; k += GT) { float sn, cs; sincospif((float)k * (2.0f / 16384.0f), &sn, &cs); TW[k] = make_float2(cs, -sn); }
                }
                if (odd) {
                    __syncthreads();
                    float* zs = (float*)lds; float* h1s = zs + 8 * 36;
                    const float* w1 = INP(29) + (size_t)jj * 33 * 64; const float* b1 = INP(30) + jj * 64; const float* w2 = INP(31) + (size_t)jj * 64 * 64; const float* b2 = INP(32) + jj * 64; const float* fr = INP(34) + jj * 64;
                    for (int tb = bid; tb < L_SEQ / 8; tb += G) {
                        __syncthreads();
                        if (tid < 8 * 33) { const int tl = tid / 33, k = tid % 33, t = tb * 8 + tl; float z;
                            if (k == 0) z = (float)t / (float)(L_SEQ - 1);
                            else { const int bnd = (k - 1) & 15; const float band = 1e-4f + (float)bnd * ((15.0f - 1e-4f) / 15.0f); const float ang = ((float)(2.0 * 3.14159265358979323846 / L_SEQ) * (float)t) * band;
                                z = (k <= 16) ? cosf(ang) : -sinf(ang); }
                            zs[tl * 36 + k] = z; }
                        __syncthreads();
                        const int tl = tid >> 6, j = tid & 63;
                        { float a = b1[j];
                            for (int k = 0; k < 33; ++k) a += zs[tl * 36 + k] * w1[k * 64 + j];
                            h1s[tl * 64 + j] = sinf(fr[j] * a); }
                        __syncthreads();
                        { float a = b2[j];
                            for (int k = 0; k < 64; ++k) a += h1s[tl * 64 + k] * w2[k * 64 + j];
                            H2[(size_t)(tb * 8 + tl) * 64 + j] = sinf(fr[j] * a); }
                    }
                }
            } else if (op == OP_F2) {
                if (!odd) continue;
                float* hs = (float*)lds; float* KT = (float*)(R + R_KT); float* PART = (float*)(ws + WS_PART);
                const float* w3 = INP(33) + (size_t)jj * 64 * 2048;
                for (int it = bid; it < 512; it += G) {
                    const int tt = it >> 2, cq = it & 3;
                    __syncthreads();
                    for (int e = tid; e < 64 * 64; e += 512) hs[(e >> 6) * 65 + (e & 63)] = H2[(size_t)tt * 4096 + e];
                    __syncthreads();
                    const int t = tt * 64 + lane; const float tn = (float)t / (float)(L_SEQ - 1);
                    for (int i = 0; i < 16; ++i) {
                        const int col = cq * 512 + wave * 64 + 4 * i;
                        float a0 = 0.f, a1 = 0.f, a2 = 0.f, a3 = 0.f;
#pragma unroll 8
                        for (int k = 0; k < 64; ++k) { const float h = hs[lane * 65 + k]; const f32x4 w = *(const f32x4*)(w3 + (size_t)k * 2048 + col); a0 += h * w.x; a1 += h * w.y; a2 += h * w.z; a3 += h * w.w; }
                        const int o = col >> 10, dir = (col >> 9) & 1, c0 = col & 511;
                        float av[4] = {a0, a1, a2, a3};
#pragma unroll
                        for (int e = 0; e < 4; ++e) { const int c = c0 + e;
                            const float lo_ = -4.605170185988091f / 1.5f, hi_ = -4.605170185988091f / 0.3f;
                            const float delta = fabsf(lo_ + (float)c * ((hi_ - lo_) / 511.0f));
                            const float v = av[e] * expf(-tn * delta);
                            const float sa = wave_sum(fabsf(v));
                            if (lane == 0) PART[(size_t)tt * 2048 + col + e] = sa;
                            float* kr = KT + (size_t)(o * 512 + c) * NFFT;
                            if (dir == 0) kr[t] = v; else if (t > 0) kr[NFFT - t] = v; else KT0B[o * 512 + c] = v; }
                    }
                }
            } else if (op == OP_F3) {
                if (!odd) continue;
                float2* x = (float2*)lds; const float* KT = (const float*)(R + R_KT); unsigned* SPEC = (unsigned*)(R + R_SPEC);
                for (int f = bid; f < 1024; f += G) {
                    __syncthreads();
                    const float* kr = KT + (size_t)f * NFFT;
                    for (int p = tid; p < NFFT; p += 512) { float v = (p == L_SEQ) ? 0.f : kr[p]; if (p == 0) v += KT0B[f]; x[p] = make_float2(v, 0.f); }
                    __syncthreads();
                    fft_fwd(x, TW, tid);
                    float nsum; { const float* PART = (const float*)(ws + WS_PART) + (size_t)(f >> 9) * 1024 + (f & 511);
                        nsum = (PART[(size_t)lane * 2048] + PART[(size_t)lane * 2048 + 512]) + (PART[(size_t)(lane + 64) * 2048] + PART[(size_t)(lane + 64) * 2048 + 512]); nsum = wave_sum(nsum); }
                    const float inv = 1.0f / ((nsum + 1e-6f) * (float)NFFT);
                    for (int p = tid; p < NFFT; p += 512) { const float2 a = x[p]; SPEC[(size_t)f * NFFT + p] = pk2(a.x * inv, a.y * inv); }
                }
            } else if (op == OP_MIX1) {
                if (!odd) {
                    const bf16* P = (const bf16*)(R + R_P); const float* cw = INP(15) + (size_t)jj * 3 * 512;
                    for (int item = gt; item < T_TOK * 128; item += GT) {
                        const int row = item >> 7, c8 = item & 127, t = row & (L_SEQ - 1);
                        float o[8];
                        if (c8 < 64) {
                            const int c = c8 * 8, h = 1 << (c >> 7); const int lo = max(t - h, 0), hi = min(t + h, L_SEQ);
                            float s[8] = {0.f, 0.f, 0.f, 0.f, 0.f, 0.f, 0.f, 0.f};
                            const bf16* base = P + (size_t)(row - t) * 2048 + c;
                            for (int tau = lo; tau < hi; ++tau) { const u32x4 w = *(const u32x4*)(base + (size_t)tau * 2048);
                                s[0] += pg8::bfl(w.x); s[1] += pg8::bfh(w.x); s[2] += pg8::bfl(w.y); s[3] += pg8::bfh(w.y); s[4] += pg8::bfl(w.z); s[5] += pg8::bfh(w.z); s[6] += pg8::bfl(w.w); s[7] += pg8::bfh(w.w); }
                            const u32x4 w = *(const u32x4*)(base + (size_t)t * 2048); const float ic = 1.0f / (float)(hi - lo);
                            o[0] = s[0] * ic - pg8::bfl(w.x); o[1] = s[1] * ic - pg8::bfh(w.x); o[2] = s[2] * ic - pg8::bfl(w.y); o[3] = s[3] * ic - pg8::bfh(w.y);
                            o[4] = s[4] * ic - pg8::bfl(w.z); o[5] = s[5] * ic - pg8::bfh(w.z); o[6] = s[6] * ic - pg8::bfl(w.w); o[7] = s[7] * ic - pg8::bfh(w.w);
                        } else {
                            const int c = (c8 - 64) * 8; const bf16* pr = P + (size_t)row * 2048 + c;
                            float acc[8] = {0.f, 0.f, 0.f, 0.f, 0.f, 0.f, 0.f, 0.f};
#pragma unroll
                            for (int dt = -1; dt <= 1; ++dt) {
                                if (t + dt < 0 || t + dt >= L_SEQ) continue;
                                const u32x4 cg_ = *(const u32x4*)(pr + (ptrdiff_t)dt * 2048 + 1024), hv = *(const u32x4*)(pr + (ptrdiff_t)dt * 2048 + 1536);
                                const f32x4 wa = *(const f32x4*)(cw + (dt + 1) * 512 + c), wb = *(const f32x4*)(cw + (dt + 1) * 512 + c + 4);
                                acc[0] += wa.x * pg8::bfl(cg_.x) * pg8::bfl(hv.x); acc[1] += wa.y * pg8::bfh(cg_.x) * pg8::bfh(hv.x); acc[2] += wa.z * pg8::bfl(cg_.y) * pg8::bfl(hv.y); acc[3] += wa.w * pg8::bfh(cg_.y) * pg8::bfh(hv.y);
                                acc[4] += wb.x * pg8::bfl(cg_.z) * pg8::bfl(hv.z); acc[5] += wb.y * pg8::bfh(cg_.z) * pg8::bfh(hv.z); acc[6] += wb.z * pg8::bfl(cg_.w) * pg8::bfl(hv.w); acc[7] += wb.w * pg8::bfh(cg_.w) * pg8::bfh(hv.w);
                            }
                            const u32x4 bg = *(const u32x4*)(pr + 512);
                            o[0] = acc[0] * pg8::bfl(bg.x); o[1] = acc[1] * pg8::bfh(bg.x); o[2] = acc[2] * pg8::bfl(bg.y); o[3] = acc[3] * pg8::bfh(bg.y);
                            o[4] = acc[4] * pg8::bfl(bg.z); o[5] = acc[5] * pg8::bfh(bg.z); o[6] = acc[6] * pg8::bfl(bg.w); o[7] = acc[7] * pg8::bfh(bg.w);
                        }
                        u32x4 w; w.x = pk2(o[0], o[1]); w.y = pk2(o[2], o[3]); w.z = pk2(o[4], o[5]); w.w = pk2(o[6], o[7]);
                        *(u32x4*)(MIXIN + (size_t)row * D + c8 * 8) = w;
                    }
                } else {
                    const bf16* PS5 = (const bf16*)(R + R_PS5);
                    for (int bt = bid; bt < 256; bt += G) {
                        const int bgi = bt & 63, b = bgi >> 5, gq = bgi & 31, chunk = (bt >> 6) * 8 + wave, n = lane;
                        float br[16], bi[16];
                        { const float* pr = INP(21) + ((size_t)(jj * 32 + gq) * 64 + n) * 16; const float* pi = INP(22) + ((size_t)(jj * 32 + gq) * 64 + n) * 16;
#pragma unroll
                            for (int q = 0; q < 4; ++q) { const f32x4 a = *(const f32x4*)(pr + 4 * q), c = *(const f32x4*)(pi + 4 * q);
                                br[4 * q] = a.x; br[4 * q + 1] = a.y; br[4 * q + 2] = a.z; br[4 * q + 3] = a.w; bi[4 * q] = c.x; bi[4 * q + 1] = c.y; bi[4 * q + 2] = c.z; bi[4 * q + 3] = c.w; } }
                        for (int d = 0; d < 2; ++d) {
                            const size_t li = ((size_t)(jj * 2 + d) * 32 + gq) * 64 + n;
                            const float lr = fminf(INP(18)[li], -1e-4f), lim = INP(19)[li], dtv = expf(INP(20)[(jj * 2 + d) * 32 + gq]);
                            const float mag = expf(lr * dtv); float sn, cs; sincosf(lim * dtv, &sn, &cs); const float ar = mag * cs, ai = mag * sn;
                            float sr = 0.f, si = 0.f;
                            const bf16* ub = PS5 + ((size_t)b * L_SEQ + chunk * 256) * 512 + gq * 16;
#pragma unroll 4
                            for (int st = 0; st < 256; ++st) {
                                const int tl = d ? 255 - st : st;
                                const u32x4 u0 = *(const u32x4*)(ub + (size_t)tl * 512), u1 = *(const u32x4*)(ub + (size_t)tl * 512 + 8);
                                const float u[16] = {pg8::bfl(u0.x), pg8::bfh(u0.x), pg8::bfl(u0.y), pg8::bfh(u0.y), pg8::bfl(u0.z), pg8::bfh(u0.z), pg8::bfl(u0.w), pg8::bfh(u0.w),
                                                     pg8::bfl(u1.x), pg8::bfh(u1.x), pg8::bfl(u1.y), pg8::bfh(u1.y), pg8::bfl(u1.z), pg8::bfh(u1.z), pg8::bfl(u1.w), pg8::bfh(u1.w)};
                                float bur = 0.f, bui = 0.f;
#pragma unroll
                                for (int q = 0; q < 16; ++q) { bur += br[q] * u[q]; bui += bi[q] * u[q]; }
                                const float nr = ar * sr - ai * si + bur, ni = ar * si + ai * sr + bui; sr = nr; si = ni;
                            }
                            S5F[((((size_t)d * 2 + b) * 32 + gq) * 32 + chunk) * 64 + n] = make_float2(sr, si);
                        }
                    }
                    __syncthreads();
                    float2* x = (float2*)lds; const bf16* PT = (const bf16*)(R + R_PT); const unsigned* SPEC = (const unsigned*)(R + R_SPEC); bf16* YT = (bf16*)(R + R_YT);
                    const float* sw = INP(27) + (size_t)jj * 3 * 1536; const float* sbv = INP(28) + (size_t)jj * 1536; const float* hb = INP(35) + (size_t)jj * 2 * 512;
                    for (int c = bid; c < 512; c += G) {
                        const bf16* r_go = PT + (size_t)c * T_TOK; const bf16* r_gm = PT + (size_t)(512 + c) * T_TOK; const bf16* r_v = PT + (size_t)(1024 + c) * T_TOK;
                        const float go0 = sw[c], go1 = sw[1536 + c], go2 = sw[3072 + c], gob = sbv[c];
                        const float gm0 = sw[512 + c], gm1 = sw[1536 + 512 + c], gm2 = sw[3072 + 512 + c], gmb = sbv[512 + c];
                        const float v0 = sw[1024 + c], v1 = sw[1536 + 1024 + c], v2 = sw[3072 + 1024 + c], vb = sbv[1024 + c];
                        const float bias0 = hb[c], bias1 = hb[512 + c];
                        __syncthreads();
                        for (int t = tid; t < L_SEQ; t += 512) { x[t] = make_float2(hy_sc(r_v, t, v0, v1, v2, vb), hy_sc(r_v + L_SEQ, t, v0, v1, v2, vb)); x[L_SEQ + t] = make_float2(0.f, 0.f); }
                        __syncthreads();
                        fft_fwd(x, TW, tid); spec_mul(x, SPEC + (size_t)c * NFFT, tid); fft_inv(x, TW, tid);
                        float2 zr[16];
#pragma unroll
                        for (int i = 0; i < 16; ++i) { const int t = tid + 512 * i; const float2 y1 = x[t];
                            const float va = hy_sc(r_v, t, v0, v1, v2, vb), vbb = hy_sc(r_v + L_SEQ, t, v0, v1, v2, vb);
                            const float ga = hy_sc(r_gm, t, gm0, gm1, gm2, gmb), gb = hy_sc(r_gm + L_SEQ, t, gm0, gm1, gm2, gmb);
                            zr[i] = make_float2(ga * (y1.x + va * bias0), gb * (y1.y + vbb * bias0));
                            x[t] = zr[i]; x[L_SEQ + t] = make_float2(0.f, 0.f); }
                        __syncthreads();
                        fft_fwd(x, TW, tid); spec_mul(x, SPEC + (size_t)(512 + c) * NFFT, tid); fft_inv(x, TW, tid);
#pragma unroll
                        for (int i = 0; i < 16; ++i) { const int t = tid + 512 * i; const float2 y2 = x[t];
                            const float ga = hy_sc(r_go, t, go0, go1, go2, gob), gb = hy_sc(r_go + L_SEQ, t, go0, go1, go2, gob);
                            YT[(size_t)c * T_TOK + t] = (bf16)f2bf(ga * (y2.x + zr[i].x * bias1));
                            YT[(size_t)c * T_TOK + L_SEQ + t] = (bf16)f2bf(gb * (y2.y + zr[i].y * bias1)); }
                    }
                }
            } else if (op == OP_MIX2) {
                if (!odd) continue;
                const bf16* PS5 = (const bf16*)(R + R_PS5); float* Y = (float*)(R + R_Y); bf16* Gb = (bf16*)(R + R_G);
                float2* CL = (float2*)lds; float2* tile = (float2*)(lds + 16384) + wave * (16 * 65);
                for (int bt = bid; bt < 256; bt += G) {
                    const int bgi = bt & 63, b = bgi >> 5, gq = bgi & 31, chunk = (bt >> 6) * 8 + wave, n = lane;
                    __syncthreads();
                    for (int e = tid; e < 2048; e += 512) { const int d = e >> 10, nn = (e >> 4) & 63, h = e & 15;
                        const size_t li = ((size_t)(jj * 2 + d) * 32 + gq) * 64 + nn;
                        const float lr = fminf(INP(18)[li], -1e-4f), lim = INP(19)[li], dtv = expf(INP(20)[(jj * 2 + d) * 32 + gq]);
                        const float mag = expf(lr * dtv); float sn, cs; sincosf(lim * dtv, &sn, &cs); const float ar = mag * cs - 1.f, ai = mag * sn;
                        const float den = 1.f / (lr * lr + lim * lim); const float cr = (ar * lr + ai * lim) * den, ci = (ai * lr - ar * lim) * den;
                        const size_t cidx = (((size_t)(jj * 2 + d) * 32 + gq) * 16 + h) * 64 + nn; const float xr = INP(23)[cidx], xi = INP(24)[cidx];
                        CL[e] = make_float2(xr * cr - xi * ci, xr * ci + xi * cr); }
                    __syncthreads();
                    float br[16], bi[16];
                    { const float* pr = INP(21) + ((size_t)(jj * 32 + gq) * 64 + n) * 16; const float* pi = INP(22) + ((size_t)(jj * 32 + gq) * 64 + n) * 16;
#pragma unroll
                        for (int q = 0; q < 4; ++q) { const f32x4 a = *(const f32x4*)(pr + 4 * q), c = *(const f32x4*)(pi + 4 * q);
                            br[4 * q] = a.x; br[4 * q + 1] = a.y; br[4 * q + 2] = a.z; br[4 * q + 3] = a.w; bi[4 * q] = c.x; bi[4 * q + 1] = c.y; bi[4 * q + 2] = c.z; bi[4 * q + 3] = c.w; } }
                    const int tl16 = lane & 15, hq = lane >> 4;
                    const f32x4 dsk = *(const f32x4*)(INP(25) + (size_t)jj * 512 + gq * 16 + 4 * hq);
                    for (int d = 0; d < 2; ++d) {
                        if (d) { __threadfence_block(); asm volatile("s_waitcnt vmcnt(0)" ::: "memory"); }
                        const size_t li = ((size_t)(jj * 2 + d) * 32 + gq) * 64 + n;
                        const float lr = fminf(INP(18)[li], -1e-4f), lim = INP(19)[li], dtv = expf(INP(20)[(jj * 2 + d) * 32 + gq]);
                        const float mag = expf(lr * dtv); float sn, cs; sincosf(lim * dtv, &sn, &cs); const float ar = mag * cs, ai = mag * sn;
                        float pr_ = ar, pi_ = ai;
#pragma unroll
                        for (int q = 0; q < 8; ++q) { const float t0 = pr_ * pr_ - pi_ * pi_, t1 = 2.f * pr_ * pi_; pr_ = t0; pi_ = t1; }
                        float sr = 0.f, si = 0.f;
                        const float2* Fb = S5F + ((((size_t)d * 2 + b) * 32 + gq) * 32) * 64 + n;
                        if (d == 0) { for (int cc = 0; cc < chunk; ++cc) { const float2 f = Fb[(size_t)cc * 64]; const float nr = pr_ * sr - pi_ * si + f.x, ni = pr_ * si + pi_ * sr + f.y; sr = nr; si = ni; } }
                        else { for (int cc = 31; cc > chunk; --cc) { const float2 f = Fb[(size_t)cc * 64]; const float nr = pr_ * sr - pi_ * si + f.x, ni = pr_ * si + pi_ * sr + f.y; sr = nr; si = ni; } }
                        const size_t rowc = (size_t)b * L_SEQ + chunk * 256;
                        const bf16* ub = PS5 + rowc * 512 + gq * 16;
                        const float2* CLd = CL + d * 1024;
                        for (int sc = 0; sc < 16; ++sc) {
#pragma unroll 4
                            for (int i = 0; i < 16; ++i) {
                                const int st = sc * 16 + i, tl = d ? 255 - st : st;
                                const u32x4 u0 = *(const u32x4*)(ub + (size_t)tl * 512), u1 = *(const u32x4*)(ub + (size_t)tl * 512 + 8);
                                const float u[16] = {pg8::bfl(u0.x), pg8::bfh(u0.x), pg8::bfl(u0.y), pg8::bfh(u0.y), pg8::bfl(u0.z), pg8::bfh(u0.z), pg8::bfl(u0.w), pg8::bfh(u0.w),
                                                     pg8::bfl(u1.x), pg8::bfh(u1.x), pg8::bfl(u1.y), pg8::bfh(u1.y), pg8::bfl(u1.z), pg8::bfh(u1.z), pg8::bfl(u1.w), pg8::bfh(u1.w)};
                                float bur = 0.f, bui = 0.f;
#pragma unroll
                                for (int q = 0; q < 16; ++q) { bur += br[q] * u[q]; bui += bi[q] * u[q]; }
                                const float nr = ar * sr - ai * si + bur, ni = ar * si + ai * sr + bui; sr = nr; si = ni;
                                tile[i * 65 + n] = make_float2(sr, si);
                            }
                            LDS_FENCE();
                            float a0 = 0.f, a1 = 0.f, a2 = 0.f, a3 = 0.f;
#pragma unroll 8
                            for (int nn = 0; nn < 64; ++nn) { const float2 s = tile[tl16 * 65 + nn]; const f32x4 c01 = *(const f32x4*)(CLd + nn * 16 + 4 * hq), c23 = *(const f32x4*)(CLd + nn * 16 + 4 * hq + 2);
                                a0 += c01.x * s.x - c01.y * s.y; a1 += c01.z * s.x - c01.w * s.y; a2 += c23.x * s.x - c23.y * s.y; a3 += c23.z * s.x - c23.w * s.y; }
                            LDS_FENCE();
                            const int st = sc * 16 + tl16, tl = d ? 255 - st : st; const size_t row = rowc + tl;
                            float* yp = Y + row * 512 + gq * 16 + 4 * hq;
                            if (d == 0) { *(f32x4*)yp = (f32x4){a0, a1, a2, a3}; }
                            else { const f32x4 yf = *(const f32x4*)yp; const u32x2 uw = *(const u32x2*)(PS5 + row * 512 + gq * 16 + 4 * hq);
                                const float y0 = yf.x + a0 + dsk.x * pg8::bfl(uw.x), y1 = yf.y + a1 + dsk.y * pg8::bfh(uw.x), y2 = yf.z + a2 + dsk.z * pg8::bfl(uw.y), y3 = yf.w + a3 + dsk.w * pg8::bfh(uw.y);
                                u32x2 w; w.x = pk2(gelu_tanh(y0), gelu_tanh(y1)); w.y = pk2(gelu_tanh(y2), gelu_tanh(y3));
                                *(u32x2*)(Gb + row * 512 + gq * 16 + 4 * hq) = w; }
                        }
                    }
                }
                __syncthreads();
                { bf16* ts = (bf16*)lds + wave * (64 * 66); const bf16* YT = (const bf16*)(R + R_YT);
                  for (int it = gw; it < 8 * 256; it += NGW) { const int cb = it & 7, tb = it >> 3;
                      for (int cl = 0; cl < 64; ++cl) ts[cl * 66 + lane] = YT[(size_t)(cb * 64 + cl) * T_TOK + tb * 64 + lane];
                      LDS_FENCE();
                      for (int tl = 0; tl < 64; ++tl) MIXIN[(size_t)(tb * 64 + tl) * D + 512 + cb * 64 + lane] = ts[lane * 66 + tl];
                      LDS_FENCE(); } }
            } else if (op == OP_SOFTMAX) {
                const float* SC = (const float*)(R + R_SC); bf16* PR = (bf16*)(R + R_PROB);
                for (int it = gw; it < T_TOK * 4; it += NGW) {
                    const f32x4 s = *((const f32x4*)(SC + (size_t)it * 256) + lane);
                    const float m = wave_max(fmaxf(fmaxf(s.x, s.y), fmaxf(s.z, s.w)));
                    const float e0 = __expf(s.x - m), e1 = __expf(s.y - m), e2 = __expf(s.z - m), e3 = __expf(s.w - m);
                    const float inv = 1.f / wave_sum((e0 + e1) + (e2 + e3));
                    u32x2 w; w.x = pk2(e0 * inv, e1 * inv); w.y = pk2(e2 * inv, e3 * inv);
                    *((u32x2*)(PR + (size_t)it * 256) + lane) = w;
                }
            } else if (op == OP_NORM_MIX || op == OP_NORM_XA || op == OP_NORM_MLP) {
                const float* gpost = (op == OP_NORM_MIX) ? INP(2) + (size_t)(layer * 2 + 1) * D : (op == OP_NORM_XA) ? INP(3) + (size_t)(layer * 2 + 1) * D : INP(5) + (size_t)(layer * 2 + 1) * D;
                const float* gpre = (op == OP_NORM_MIX) ? INP(3) + (size_t)(layer * 2) * D : (op == OP_NORM_XA) ? INP(5) + (size_t)(layer * 2) * D : INP(2) + (size_t)((layer + 1) * 2) * D;
                const bool want_hn = !(op == OP_NORM_MLP && layer == 3);
                for (int m = gw; m < T_TOK; m += NGW) norm_row(X + (size_t)m * D, X + (size_t)m * D, MIXOUT + (size_t)m * D, gpost, gpre, want_hn ? HN + (size_t)m * D : nullptr, lane);
            } else { continue; }
            GRID_SYNC();
        }
    }
}

extern "C" void kernel_launch(void* const* d_in, const int* in_sizes, int n_in, void* d_out, int out_size, void* d_ws, size_t ws_size, hipStream_t stream) {
    static int grid = 0;
    if (grid == 0) {
        if (n_in != 37 || out_size != T_TOK * D || ws_size < WS_END) { fprintf(stderr, "kernel_launch: unexpected shapes (n_in %d out %d ws %zu, need ws >= %zu)\n", n_in, out_size, ws_size, (size_t)WS_END); grid = -1; return; }
        int dev = 0, cus = 0, per_cu = 0;
        (void)hipGetDevice(&dev);
        (void)hipDeviceGetAttribute(&cus, hipDeviceAttributeMultiprocessorCount, dev);
        (void)hipFuncSetAttribute((const void*)fwd_kernel, hipFuncAttributeMaxDynamicSharedMemorySize, LDS_BYTES);
        (void)hipOccupancyMaxActiveBlocksPerMultiprocessor(&per_cu, (const void*)fwd_kernel, 512, LDS_BYTES);
        (void)hipGetLastError();
        grid = cus > 0 ? cus : 256;
        fprintf(stderr, "kernel_launch: grid %d (per_cu %d) ws %zu\n", grid, per_cu, ws_size);
    }
    if (grid < 0) return;
    if (hipMemsetAsync((char*)d_ws + WS_BAR, 0, WS_BAR_BYTES, stream) != hipSuccess) { fprintf(stderr, "kernel_launch: memset failed\n"); return; }
    Args a{};
    for (int i = 0; i < 37; ++i) a.in[i] = (const float*)d_in[i];
    a.out = (float*)d_out; a.ws = (unsigned char*)d_ws;
    void* kargs[] = {&a};
    hipError_t e = hipLaunchCooperativeKernel((void*)fwd_kernel, dim3(grid), dim3(512), kargs, LDS_BYTES, stream);
    if (e != hipSuccess) fprintf(stderr, "kernel_launch: cooperative launch failed: %s\n", hipGetErrorString(e));
}
```

```cpp
#include <hip/hip_runtime.h>
#include <hip/hip_cooperative_groups.h>
#include <cstdio>
#include <cstdint>
namespace cg = cooperative_groups;

namespace pg8 {
#define PG8_LAS __attribute__((address_space(3)))
typedef unsigned short bf16_t;
typedef short bf16x8 __attribute__((ext_vector_type(8)));
typedef float f32x4 __attribute__((ext_vector_type(4)));
typedef unsigned u32x4 __attribute__((ext_vector_type(4)));
constexpr int BM = 256, BK = 64, HALF = 128, HTB = HALF * BK * 2  , STAGE_BYTES = 8 * HTB, NXCD = 8, WGM = 8;

__host__ __device__ __forceinline__ int lds_byte(int r, int c) { const int st = (r >> 4) * 2 + (c >> 5), rr = r & 15, cc = c & 31, ob = rr * 64 + cc * 2; return st * 1024 + (ob ^ (((ob >> 9) & 1) << 5)); }
__host__ __device__ __forceinline__ void stage_rc(int b, int& R, int& C) { const int st = b / 1024, sb = b % 1024, swz = sb ^ (((sb >> 9) & 1) << 5); R = (st >> 1) * 16 + swz / 64; C = (st & 1) * 32 + (swz % 64) / 2; }
__host__ __device__ __forceinline__ int perm32(int rho) { const int n = rho >> 4, i = rho & 15; return 8 * (i >> 2) + 4 * n + (i & 3); }

struct Unit { int pm, pn; const char* a; const char* b; };
struct Gemm { int K, lda, ldb; };

struct Sched {
    int nM, nN, nwg, G, c; const char* A; const char* Bt; size_t sa_m, sa_n, sb_n, sb_b;
    __device__ __forceinline__ bool next(int i, Unit& u) const {
        const long L = (long)i * G + c; if (L >= nwg) return false;
        int wgid = (int)L; { const int q = nwg / NXCD, r = nwg % NXCD, xcd = wgid % NXCD, off = wgid / NXCD; wgid = (xcd < r ? xcd * (q + 1) : r * (q + 1) + (xcd - r) * q) + off; }
        const int nig = WGM * nN, gid = wgid / nig, fm = gid * WGM, gsz = (nM - fm) < WGM ? (nM - fm) : WGM;
        u.pm = fm + ((wgid % nig) % gsz); u.pn = (wgid % nig) / gsz;
        u.a = A + (size_t)u.pm * sa_m + (size_t)u.pn * sa_n; u.b = Bt + (size_t)u.pn * sb_n + (size_t)(u.pm >> 5) * sb_b; return true;
    }
    __device__ __forceinline__ void a_ready(const Unit&) const {}
    __device__ __forceinline__ void done(const Unit&) const {}
};

__device__ __forceinline__ unsigned cvt_pk_bf16(float lo, float hi) { unsigned r; asm volatile("v_cvt_pk_bf16_f32 %0, %1, %2" : "=v"(r) : "v"(lo), "v"(hi)); return r; }
__device__ __forceinline__ float bfl(unsigned w) { return __uint_as_float(w << 16); }
__device__ __forceinline__ float bfh(unsigned w) { return __uint_as_float(w & 0xffff0000u); }

enum { EP_BF16 = 0, EP_RELU2 = 1, EP_F32S = 2, EP_ODDIN = 3, EP_VT = 4, EP_GLU = 5 };
struct EpiRT {
    static constexpr bool PERM = true, AFTER_DRAIN = false;
    int mode; void* O; void* O2; const void* aux; int ldc; float scale;
    __device__ __forceinline__ void operator()(const f32x4 (&acc)[2][2][4][2], const Unit& u, int wr, int wc, int fr, int fq) const {
#pragma unroll
        for (int ai = 0; ai < 2; ++ai)
#pragma unroll
            for (int m = 0; m < 4; ++m) {
                const int row = u.pm * BM + ai * HALF + wr * 64 + m * 16 + fr;
#pragma unroll
                for (int bj = 0; bj < 2; ++bj) {
                    const int col = u.pn * BM + bj * HALF + wc * 32 + 8 * fq;
                    f32x4 v0 = acc[ai][bj][m][0], v1 = acc[ai][bj][m][1];
                    if (mode == EP_BF16) {
                        u32x4 w; w.x = cvt_pk_bf16(v0[0], v0[1]); w.y = cvt_pk_bf16(v0[2], v0[3]); w.z = cvt_pk_bf16(v1[0], v1[1]); w.w = cvt_pk_bf16(v1[2], v1[3]);
                        *(u32x4*)((bf16_t*)O + (size_t)row * ldc + col) = w;
                    } else if (mode == EP_RELU2) {
#pragma unroll
                        for (int e = 0; e < 4; ++e) { float a = fmaxf(v0[e], 0.f), b = fmaxf(v1[e], 0.f); v0[e] = a * a; v1[e] = b * b; }
                        u32x4 w; w.x = cvt_pk_bf16(v0[0], v0[1]); w.y = cvt_pk_bf16(v0[2], v0[3]); w.z = cvt_pk_bf16(v1[0], v1[1]); w.w = cvt_pk_bf16(v1[2], v1[3]);
                        *(u32x4*)((bf16_t*)O + (size_t)row * ldc + col) = w;
                    } else if (mode == EP_F32S) {
                        float* o = (float*)O + (size_t)row * ldc + col;
                        *(f32x4*)o = v0 * scale; *(f32x4*)(o + 4) = v1 * scale;
                    } else if (mode == EP_ODDIN) {
                        if (col < 512) {
                            u32x4 w; w.x = cvt_pk_bf16(v0[0], v0[1]); w.y = cvt_pk_bf16(v0[2], v0[3]); w.z = cvt_pk_bf16(v1[0], v1[1]); w.w = cvt_pk_bf16(v1[2], v1[3]);
                            *(u32x4*)((bf16_t*)O + (size_t)row * 512 + col) = w;
                        } else {
                            bf16_t* pt = (bf16_t*)O2 + (size_t)(col - 512) * 16384 + row;
#pragma unroll
                            for (int e = 0; e < 4; ++e) { pt[(size_t)e * 16384] = (bf16_t)(cvt_pk_bf16(v0[e], 0.f) & 0xffffu); pt[(size_t)(e + 4) * 16384] = (bf16_t)(cvt_pk_bf16(v1[e], 0.f) & 0xffffu); }
                        }
                    } else if (mode == EP_VT) {
                        bf16_t* vt = (bf16_t*)O + ((size_t)(row >> 8) * 1024 + col) * 256 + (row & 255);
#pragma unroll
                        for (int e = 0; e < 4; ++e) { vt[(size_t)e * 256] = (bf16_t)(cvt_pk_bf16(v0[e], 0.f) & 0xffffu); vt[(size_t)(e + 4) * 256] = (bf16_t)(cvt_pk_bf16(v1[e], 0.f) & 0xffffu); }
                    } else {
                        const u32x4 gw = *(const u32x4*)((const bf16_t*)aux + (size_t)row * 512 + col);
                        float g[8] = {bfl(gw.x), bfh(gw.x), bfl(gw.y), bfh(gw.y), bfl(gw.z), bfh(gw.z), bfl(gw.w), bfh(gw.w)};
                        float o[8];
#pragma unroll
                        for (int e = 0; e < 4; ++e) { o[e] = g[e] / (1.f + __expf(-v0[e])); o[e + 4] = g[e + 4] / (1.f + __expf(-v1[e])); }
                        u32x4 w; w.x = cvt_pk_bf16(o[0], o[1]); w.y = cvt_pk_bf16(o[2], o[3]); w.z = cvt_pk_bf16(o[4], o[5]); w.w = cvt_pk_bf16(o[6], o[7]);
                        *(u32x4*)((bf16_t*)O + (size_t)row * ldc + col) = w;
                    }
                }
            }
    }
};
template <class Epi, class Sched, bool ALIGN_EPI = false, bool SP2 = false>
__device__ __forceinline__ void gemm_phase(PG8_LAS unsigned char* lds, const Gemm g, const Sched& S, const Epi& E, const int tid) {
    const int wid = __builtin_amdgcn_readfirstlane(tid >> 6), lane = tid & 63, wr = wid >> 2, wc = wid & 3, fr = lane & 15, fq = lane >> 4;
    const int K = g.K, nt = K / BK;
    unsigned voffA[2], voffB[2];
#pragma unroll
    for (int i = 0; i < 2; ++i) { int R, C; stage_rc(tid * 16 + i * 8192, R, C); const int Rb = Epi::PERM ? ((R & ~31) + perm32(R & 31)) : R;
        voffA[i] = (unsigned)(R * g.lda + C) * 2u; voffB[i] = (unsigned)(Rb * g.ldb + C) * 2u; }
    const size_t kstep = (size_t)(BK * 2);
    const size_t hstepA = (size_t)HALF * g.lda * 2, hstepB = (size_t)HALF * g.ldb * 2;
    const unsigned ldsw = (unsigned)wid * 1024u;
    const int aoff = lds_byte(wr * 64 + fr, fq * 8), boff = lds_byte(wc * 32 + fr, fq * 8);
#define PG8_SA(b, h) (((b) * 2 + (h)) * HTB)
#define PG8_SB(b, h) ((4 + (b) * 2 + (h)) * HTB)
#define PG8_STAGE(bufoff, gbase, voff) do { _Pragma("unroll") for (int _i = 0; _i < 2; ++_i) \
        __builtin_amdgcn_global_load_lds((const unsigned*)((const char*)(gbase) + (voff)[_i]), (PG8_LAS unsigned*)(lds + (bufoff) + ldsw + _i * 8192), 16, 0, 0); } while (0)
#define PG8_LDA(dst, b, h) do { _Pragma("unroll") for (int m = 0; m < 4; ++m) _Pragma("unroll") for (int k = 0; k < 2; ++k) dst[m][k] = *(const PG8_LAS bf16x8*)(lds + PG8_SA(b, h) + aoff + m * 2048 + k * 1024); } while (0)
#define PG8_LDB(dst, b, h) do { _Pragma("unroll") for (int n = 0; n < 2; ++n) _Pragma("unroll") for (int k = 0; k < 2; ++k) dst[n][k] = *(const PG8_LAS bf16x8*)(lds + PG8_SB(b, h) + boff + n * 2048 + k * 1024); } while (0)
#define PG8_MMA(ai, bj, At, Bt) do { __builtin_amdgcn_s_setprio(1); _Pragma("unroll") for (int m = 0; m < 4; ++m) _Pragma("unroll") for (int n = 0; n < 2; ++n) _Pragma("unroll") for (int k = 0; k < 2; ++k) \
        acc[ai][bj][m][n] = __builtin_amdgcn_mfma_f32_16x16x32_bf16(Bt[n][k], At[m][k], acc[ai][bj][m][n], 0, 0, 0); __builtin_amdgcn_s_setprio(0); } while (0)
#define PG8_WAIT_V(n) asm volatile("s_waitcnt vmcnt(" #n ")" ::: "memory")
#define PG8_WAIT_L(n) asm volatile("s_waitcnt lgkmcnt(" #n ")" ::: "memory")
#define PG8_BAR __builtin_amdgcn_s_barrier()
#define PG8_SCHED __builtin_amdgcn_sched_barrier(0)
    Unit cur, nxt; int ui = 0;
    if (!S.next(0, cur)) return;
    f32x4 acc[2][2][4][2];
#pragma unroll
    for (int a = 0; a < 2; ++a)
#pragma unroll
        for (int b = 0; b < 2; ++b)
#pragma unroll
            for (int m = 0; m < 4; ++m)
#pragma unroll
                for (int n = 0; n < 2; ++n) acc[a][b][m][n] = (f32x4){0.f, 0.f, 0.f, 0.f};
    bf16x8 At[4][2], B0[2][2], B1[2][2];
    const char* cA = cur.a; const char* cB = cur.b;
    S.a_ready(cur);
    if constexpr (SP2) {
        PG8_STAGE(PG8_SB(0, 0), cB, voffB); PG8_STAGE(PG8_SB(0, 1), cB + hstepB, voffB); PG8_STAGE(PG8_SA(0, 0), cA, voffA); PG8_STAGE(PG8_SA(0, 1), cA + hstepA, voffA);
        if (wr == 1) PG8_BAR;
        PG8_WAIT_V(2); PG8_BAR;
        PG8_STAGE(PG8_SB(1, 0), cB + kstep, voffB); PG8_STAGE(PG8_SA(1, 0), cA + kstep, voffA); PG8_STAGE(PG8_SB(1, 1), cB + hstepB + kstep, voffB);
        PG8_WAIT_V(6); PG8_BAR;
    } else {
        PG8_STAGE(PG8_SB(0, 0), cB, voffB); PG8_STAGE(PG8_SA(0, 0), cA, voffA); PG8_STAGE(PG8_SB(0, 1), cB + hstepB, voffB); PG8_STAGE(PG8_SA(0, 1), cA + hstepA, voffA);
        if (wr == 1) PG8_BAR;
        PG8_WAIT_V(4); PG8_BAR;
        PG8_STAGE(PG8_SB(1, 0), cB + kstep, voffB); PG8_STAGE(PG8_SA(1, 0), cA + kstep, voffA); PG8_STAGE(PG8_SB(1, 1), cB + hstepB + kstep, voffB);
        PG8_WAIT_V(6); PG8_BAR;
    }
    for (;;) {
        const bool has_next = S.next(ui + 1, nxt);
        const char* nA = has_next ? nxt.a : cA; const char* nB = has_next ? nxt.b : cB;
        for (int t = 0; t < nt; t += 2) {
            const bool last = (t == nt - 2);
            const char* a1 = cA + (size_t)(t + 1) * kstep;
            const char* a2 = last ? nA : cA + (size_t)(t + 2) * kstep; const char* b2 = last ? nB : cB + (size_t)(t + 2) * kstep;
            const char* a3 = a2 + kstep; const char* b3 = b2 + kstep;
            if (last && has_next) S.a_ready(nxt);
            if constexpr (SP2) {
            PG8_LDB(B0, 0, 0); PG8_LDB(B1, 0, 1); PG8_SCHED; PG8_LDA(At, 0, 0); PG8_STAGE(PG8_SA(1, 1), a1 + hstepA, voffA);
            PG8_WAIT_V(8); PG8_WAIT_L(0); PG8_BAR; PG8_MMA(0, 0, At, B0); PG8_MMA(0, 1, At, B1); PG8_BAR; PG8_SCHED;
            PG8_LDA(At, 0, 1); PG8_STAGE(PG8_SB(0, 0), b2, voffB); PG8_STAGE(PG8_SB(0, 1), b2 + hstepB, voffB); PG8_STAGE(PG8_SA(0, 0), a2, voffA);
            PG8_WAIT_V(8); PG8_WAIT_L(0); PG8_BAR; PG8_MMA(1, 0, At, B0); PG8_MMA(1, 1, At, B1); PG8_BAR; PG8_SCHED;
            PG8_LDB(B0, 1, 0); PG8_LDB(B1, 1, 1); PG8_SCHED; PG8_LDA(At, 1, 0); PG8_STAGE(PG8_SA(0, 1), a2 + hstepA, voffA);
            PG8_WAIT_V(8); PG8_WAIT_L(0); PG8_BAR; PG8_MMA(0, 0, At, B0); PG8_MMA(0, 1, At, B1); PG8_BAR; PG8_SCHED;
            PG8_LDA(At, 1, 1); PG8_STAGE(PG8_SB(1, 0), b3, voffB); PG8_STAGE(PG8_SB(1, 1), b3 + hstepB, voffB); PG8_STAGE(PG8_SA(1, 0), a3, voffA);
            PG8_WAIT_V(8); PG8_WAIT_L(0); PG8_BAR; PG8_MMA(1, 0, At, B0); PG8_MMA(1, 1, At, B1); PG8_BAR; PG8_SCHED;
            } else {
            PG8_LDB(B0, 0, 0); PG8_SCHED; PG8_LDA(At, 0, 0); PG8_STAGE(PG8_SA(1, 1), a1 + hstepA, voffA);
            PG8_WAIT_L(8); PG8_BAR; PG8_WAIT_L(0); PG8_MMA(0, 0, At, B0); PG8_BAR; PG8_SCHED;
            PG8_LDB(B1, 0, 1); PG8_STAGE(PG8_SB(0, 0), b2, voffB);
            PG8_BAR; PG8_WAIT_L(0); PG8_MMA(0, 1, At, B1); PG8_BAR;
            PG8_LDA(At, 0, 1); PG8_STAGE(PG8_SA(0, 0), a2, voffA);
            PG8_BAR; PG8_WAIT_L(0); PG8_MMA(1, 0, At, B0); PG8_BAR; PG8_SCHED;
            PG8_STAGE(PG8_SB(0, 1), b2 + hstepB, voffB);
            PG8_WAIT_V(6); PG8_BAR; PG8_MMA(1, 1, At, B1); PG8_BAR;
            PG8_LDB(B0, 1, 0); PG8_SCHED; PG8_LDA(At, 1, 0); PG8_STAGE(PG8_SA(0, 1), a2 + hstepA, voffA);
            PG8_WAIT_L(8); PG8_BAR; PG8_WAIT_L(0); PG8_MMA(0, 0, At, B0); PG8_BAR; PG8_SCHED;
            PG8_LDB(B1, 1, 1); PG8_STAGE(PG8_SB(1, 0), b3, voffB);
            PG8_BAR; PG8_WAIT_L(0); PG8_MMA(0, 1, At, B1); PG8_BAR;
            PG8_LDA(At, 1, 1); PG8_STAGE(PG8_SA(1, 0), a3, voffA);
            PG8_BAR; PG8_WAIT_L(0); PG8_MMA(1, 0, At, B0); PG8_BAR; PG8_SCHED;
            PG8_STAGE(PG8_SB(1, 1), b3 + hstepB, voffB);
            PG8_WAIT_V(6); PG8_BAR; PG8_MMA(1, 1, At, B1); PG8_BAR;
            }
        }
        if constexpr (ALIGN_EPI) { if (wr == 0) PG8_BAR; }
        if constexpr (!Epi::AFTER_DRAIN) { E(acc, cur, wr, wc, fr, fq); S.done(cur); }
        if (!has_next) break;
#pragma unroll
        for (int a = 0; a < 2; ++a)
#pragma unroll
            for (int b = 0; b < 2; ++b)
#pragma unroll
                for (int m = 0; m < 4; ++m)
#pragma unroll
                    for (int n = 0; n < 2; ++n) acc[a][b][m][n] = (f32x4){0.f, 0.f, 0.f, 0.f};
        cur = nxt; cA = nA; cB = nB; ++ui;
        if constexpr (ALIGN_EPI) { if (wr == 1) PG8_BAR; }
    }
    PG8_WAIT_V(0);
    if constexpr (!ALIGN_EPI) { if (wr == 0) PG8_BAR; }
    PG8_BAR;
    if constexpr (Epi::AFTER_DRAIN) { E.fused(acc, cur, wr, wc, fr, fq, lds, wid, lane); S.done(cur); }
#undef PG8_SA
#undef PG8_SB
#undef PG8_STAGE
#undef PG8_LDA
#undef PG8_LDB
#undef PG8_MMA
#undef PG8_WAIT_V
#undef PG8_WAIT_L
#undef PG8_BAR
#undef PG8_SCHED
}
}

typedef unsigned short bf16;
typedef float f32x4 __attribute__((ext_vector_type(4)));
typedef unsigned u32x4 __attribute__((ext_vector_type(4)));
typedef unsigned u32x2 __attribute__((ext_vector_type(2)));
constexpr int L_SEQ = 8192, T_TOK = 16384, D = 1024, FF = 4096, NMEMT = 512;
constexpr int NFFT = 16384;
constexpr float RMS_EPS = 1e-6f;
constexpr int LDS_BYTES = 155648;
constexpr size_t MiB = 1u << 20;
constexpr size_t WS_NORMS = 0;
constexpr size_t WS_KT0B = 8192;
constexpr size_t WS_BAR = 16384, WS_BAR_BYTES = 16384;
constexpr size_t WS_TW = 65536;
constexpr size_t WS_S5F = 1 * MiB;
constexpr size_t WS_H2 = 4 * MiB;
constexpr size_t WS_MN = 6 * MiB;
constexpr size_t WS_KB = 7 * MiB;
constexpr size_t WS_VT = 8 * MiB;
constexpr size_t WS_PART = 9 * MiB;
constexpr size_t WS_W = 16 * MiB;
constexpr size_t W_IN = 0, W_OUT = 4 * MiB, W_Q = 6 * MiB, W_K = 8 * MiB, W_V = 10 * MiB, W_O = 12 * MiB, W_1 = 14 * MiB, W_2 = 22 * MiB, W_GLU = 30 * MiB;
constexpr size_t WS_HN = 48 * MiB;
constexpr size_t WS_MIXOUT = 80 * MiB;
constexpr size_t WS_MIXIN = 112 * MiB;
constexpr size_t WS_R = 144 * MiB;
constexpr size_t R_P = 0;
constexpr size_t R_Q = 0, R_SC = 32 * MiB, R_PROB = 96 * MiB;
constexpr size_t R_H = 0;
constexpr size_t R_SPEC = 0, R_KT = 64 * MiB, R_PT = 64 * MiB, R_Y = 64 * MiB, R_PS5 = 112 * MiB, R_G = 128 * MiB, R_YT = 144 * MiB;
constexpr size_t WS_END = WS_R + 160 * MiB;

struct Args { const float* in[37]; float* out; unsigned char* ws; };
constexpr int TAB_OFF = LDS_BYTES - 512;
__device__ __forceinline__ const void* ldptr(const unsigned char* lds, int i) {
    const volatile unsigned* p = (const volatile unsigned*)(lds + TAB_OFF) + 2 * i;
    const unsigned lo = __builtin_amdgcn_readfirstlane(p[0]), hi = __builtin_amdgcn_readfirstlane(p[1]);
    return (const void*)(((unsigned long long)hi << 32) | lo);
}

__device__ __forceinline__ float bf2f(bf16 v) { return __uint_as_float((unsigned)v << 16); }
__device__ __forceinline__ unsigned f2bf(float f) { unsigned u = __float_as_uint(f); return (u + 0x7fffu + ((u >> 16) & 1u)) >> 16; }
__device__ __forceinline__ unsigned pk2(float lo, float hi) { return f2bf(lo) | (f2bf(hi) << 16); }
__device__ __forceinline__ float wave_sum(float v) {
#pragma unroll
    for (int o = 1; o < 64; o <<= 1) v += __shfl_xor(v, o);
    return v;
}
__device__ __forceinline__ float wave_max(float v) {
#pragma unroll
    for (int o = 1; o < 64; o <<= 1) v = fmaxf(v, __shfl_xor(v, o));
    return v;
}
#define XB_TMO      128
#define XB_XCNT(j)  (256  + 64 * (j))
#define XB_XSUB(j)  (1280 + 64 * (j))
#define XB_XGEN(j)  (2304 + 64 * (j))
#define XB_TOP      3328
#define XB_TOPGEN   3392
#define XCD_BAR_WORDS 3456
#define XB_SPIN_CAP (1u << 18)

__device__ __forceinline__ unsigned xb_ld(unsigned* p)              { return __hip_atomic_load(p, __ATOMIC_RELAXED, __HIP_MEMORY_SCOPE_AGENT); }
__device__ __forceinline__ unsigned xb_add(unsigned* p, unsigned v) { return __hip_atomic_fetch_add(p, v, __ATOMIC_RELAXED, __HIP_MEMORY_SCOPE_AGENT); }
__device__ __forceinline__ unsigned xb_xcc_id() { return (unsigned)__builtin_amdgcn_s_getreg((3 << 11) | 20) & 0xFu; }
#define XB_SPIN(cond, bar) do { unsigned _sp = 0; while (cond) { __builtin_amdgcn_s_sleep(1); \
    if ((++_sp & 255u) == 0u) { if (xb_ld(&(bar)[XB_TMO])) break; if (_sp > XB_SPIN_CAP) { atomicAdd(&(bar)[XB_TMO], 1u); break; } } } } while (0)

struct XcdBarrier {
    unsigned* bar; unsigned x;
    volatile __attribute__((address_space(3))) unsigned* st;
};

__device__ __forceinline__ XcdBarrier xcd_barrier_post(unsigned* bar, volatile __attribute__((address_space(3))) unsigned* st) {
    XcdBarrier b; b.bar = bar; b.x = xb_xcc_id(); b.st = st;
    if (threadIdx.x == 0) (void)xb_add(&bar[XB_XCNT(b.x)], 1u);
    return b;
}
__device__ __forceinline__ void xcd_barrier_complete(unsigned* bar, unsigned x, unsigned& nloc, unsigned& nx) {
    const unsigned G = gridDim.x * gridDim.y * gridDim.z;
    unsigned sum, cnt, mine, sp = 0u;
    for (;;) {
        sum = 0u; cnt = 0u; mine = 0u;
#pragma unroll
        for (unsigned j = 0; j < 16; ++j) { const unsigned c = xb_ld(&bar[XB_XCNT(j)]); sum += c; cnt += (c > 0u) ? 1u : 0u; mine = (j == x) ? c : mine; }
        if (sum == G) break;
        __builtin_amdgcn_s_sleep(1);
        if ((++sp & 255u) == 0u) { if (xb_ld(&bar[XB_TMO])) break; if (sp > XB_SPIN_CAP) { atomicAdd(&bar[XB_TMO], 1u); break; } }
    }
    nloc = mine > 0u ? mine : 1u; nx = cnt > 0u ? cnt : 1u;
}

__device__ __forceinline__ void xcd_barrier(const XcdBarrier& b) {
    asm volatile("s_waitcnt vmcnt(0)" ::: "memory");
    __syncthreads();
    if (threadIdx.x == 0) {
        unsigned* bar = b.bar;
        __builtin_amdgcn_s_waitcnt(0);
        unsigned nloc = b.st[0], nx = b.st[1];
        if (nloc == 0u) { xcd_barrier_complete(bar, b.x, nloc, nx); b.st[0] = nloc; b.st[1] = nx; }
        const unsigned old = xb_add(&bar[XB_XSUB(b.x)], 1u);
        const unsigned gen = old / nloc;
        if (old + 1u == (gen + 1u) * nloc) {
            __builtin_amdgcn_fence(__ATOMIC_RELEASE, "agent");
            asm volatile("s_waitcnt vmcnt(0)" ::: "memory");
            const unsigned og = xb_add(&bar[XB_TOP], 1u);
            const unsigned tg = og / nx;
            if (og + 1u == (tg + 1u) * nx) xb_add(&bar[XB_TOPGEN], 1u);
            else XB_SPIN(xb_ld(&bar[XB_TOPGEN]) == tg, bar);
            __builtin_amdgcn_fence(__ATOMIC_ACQUIRE, "agent");
            xb_add(&bar[XB_XGEN(b.x)], 1u);
            asm volatile("s_waitcnt vmcnt(0)" ::: "memory");
        } else {
            XB_SPIN(xb_ld(&bar[XB_XGEN(b.x)]) == gen, bar);
            __builtin_amdgcn_fence(__ATOMIC_ACQUIRE, "agent");
            asm volatile("s_waitcnt vmcnt(0)" ::: "memory");
        }
    }
    __syncthreads();
}

#define LDS_FENCE() asm volatile("s_waitcnt lgkmcnt(0)" ::: "memory")

__device__ __forceinline__ void transpose_item(const float* W, int ldw, int ncols, bf16* WT, int ldt, float* scr, int item, int lane) {
    const int nblk = ncols / 32, kb = item / nblk, nb = item % nblk, k0 = 64 * kb, n0 = 32 * nb;
#pragma unroll 8
    for (int i = 0; i < 32; ++i) { const int kk = 2 * i + (lane >> 5); scr[kk * 33 + (lane & 31)] = W[(size_t)(k0 + kk) * ldw + n0 + (lane & 31)]; }
    LDS_FENCE();
    const int c = lane & 7;
#pragma unroll
    for (int j = 0; j < 4; ++j) { const int n = (lane >> 3) + 8 * j; const float* s = scr + (8 * c) * 33 + n;
        u32x4 o; o.x = pk2(s[0 * 33], s[1 * 33]); o.y = pk2(s[2 * 33], s[3 * 33]); o.z = pk2(s[4 * 33], s[5 * 33]); o.w = pk2(s[6 * 33], s[7 * 33]);
        *(u32x4*)(WT + (size_t)(n0 + n) * ldt + k0 + 8 * c) = o; }
    LDS_FENCE();
}

__device__ __forceinline__ void norm_row(const float* xin, float* xout, const bf16* br, const float* gpost, const float* gpre, bf16* hn, int lane) {
    f32x4 v[4];
#pragma unroll
    for (int j = 0; j < 4; ++j) v[j] = *((const f32x4*)xin + lane + 64 * j);
    if (br) {
        f32x4 r[4]; float ss = 0.f;
#pragma unroll
        for (int j = 0; j < 4; ++j) { const u32x2 w = *((const u32x2*)br + lane + 64 * j);
            r[j] = (f32x4){pg8::bfl(w.x), pg8::bfh(w.x), pg8::bfl(w.y), pg8::bfh(w.y)}; ss += (r[j].x * r[j].x + r[j].y * r[j].y) + (r[j].z * r[j].z + r[j].w * r[j].w); }
        const float rstd = rsqrtf(wave_sum(ss) * (1.f / D) + RMS_EPS);
#pragma unroll
        for (int j = 0; j < 4; ++j) { const f32x4 g = *((const f32x4*)gpost + lane + 64 * j); v[j] = v[j] + r[j] * rstd * g; }
    }
    if (xout) {
#pragma unroll
        for (int j = 0; j < 4; ++j) *((f32x4*)xout + lane + 64 * j) = v[j];
    }
    if (hn) {
        float ss = 0.f;
#pragma unroll
        for (int j = 0; j < 4; ++j) ss += (v[j].x * v[j].x + v[j].y * v[j].y) + (v[j].z * v[j].z + v[j].w * v[j].w);
        const float rstd = rsqrtf(wave_sum(ss) * (1.f / D) + RMS_EPS);
#pragma unroll
        for (int j = 0; j < 4; ++j) { const f32x4 g = *((const f32x4*)gpre + lane + 64 * j); const f32x4 o = v[j] * rstd * g;
            u32x2 w; w.x = pk2(o.x, o.y); w.y = pk2(o.z, o.w); *((u32x2*)hn + lane + 64 * j) = w; }
    }
}

#define PADI(i) ((i) + (((i) >> 6) << 2))
constexpr int FFT_LDS_ELEMS = 16384 + 1024;
constexpr int TWL_OFF = FFT_LDS_ELEMS * 8;
__device__ __forceinline__ float2 cmul(float2 a, float2 b) { return make_float2(a.x * b.x - a.y * b.y, a.x * b.y + a.y * b.x); }
__device__ __forceinline__ float2 cmulc(float2 a, float2 b) { return make_float2(a.x * b.x + a.y * b.y, a.y * b.x - a.x * b.y); }
template <bool INV> __device__ __forceinline__ void fft16(float2 (&r)[16]) {
    const float C[8] = {1.f, 0.9238795325112867f, 0.7071067811865476f, 0.3826834323650898f, 0.f, -0.3826834323650898f, -0.7071067811865476f, -0.9238795325112867f};
    const float S[8] = {0.f, 0.3826834323650898f, 0.7071067811865476f, 0.9238795325112867f, 1.f, 0.9238795325112867f, 0.7071067811865476f, 0.3826834323650898f};
#pragma unroll
    for (int st = 0; st < 4; ++st) {
        const int ls = INV ? st : 3 - st, s = 1 << ls;
#pragma unroll
        for (int b = 0; b < 8; ++b) {
            const int off = b & (s - 1), i = ((b >> ls) << (ls + 1)) + off, k = off << (3 - ls);
            const float2 a = r[i], c = r[i + s];
            if (!INV) {
                const float2 d = make_float2(a.x - c.x, a.y - c.y);
                r[i] = make_float2(a.x + c.x, a.y + c.y);
                if (k == 0) r[i + s] = d; else if (k == 4) r[i + s] = make_float2(d.y, -d.x); else r[i + s] = cmul(d, make_float2(C[k], -S[k]));
            } else {
                float2 bb; if (k == 0) bb = c; else if (k == 4) bb = make_float2(-c.y, c.x); else bb = cmulc(c, make_float2(C[k], -S[k]));
                r[i] = make_float2(a.x + bb.x, a.y + bb.y); r[i + s] = make_float2(a.x - bb.x, a.y - bb.y);
            }
        }
    }
}
template <bool INV, int LSM> __device__ __forceinline__ void fft_pass16(float2* x, const float2* twl, int tid) {
    constexpr int SH = 10 - LSM;
    constexpr int QS = (LSM >= 6) ? ((1 << LSM) + ((1 << LSM) >> 4)) : (1 << LSM);
#pragma unroll 1
    for (int w = tid; w < 1024; w += 512) {
        const int j = w & ((1 << LSM) - 1), base = (w >> LSM) << (LSM + 4);
        float2* px = x + PADI(base + j);
        float2 r[16];
#pragma unroll
        for (int q = 0; q < 16; ++q) r[q] = px[q * QS];
        const float2 th = twl[j << SH];
        float2 pw[16];
        pw[1] = th; pw[2] = cmul(th, th); pw[3] = cmul(pw[2], th); pw[4] = cmul(pw[2], pw[2]); pw[5] = cmul(pw[4], th); pw[6] = cmul(pw[3], pw[3]); pw[7] = cmul(pw[6], th);
        pw[8] = cmul(pw[4], pw[4]); pw[9] = cmul(pw[8], th); pw[10] = cmul(pw[5], pw[5]); pw[11] = cmul(pw[10], th); pw[12] = cmul(pw[6], pw[6]); pw[13] = cmul(pw[12], th); pw[14] = cmul(pw[7], pw[7]); pw[15] = cmul(pw[14], th);
        if (!INV) fft16<false>(r);
#pragma unroll
        for (int p = 1; p < 16; ++p) { const int br = ((p & 1) << 3) | ((p & 2) << 1) | ((p & 4) >> 1) | ((p & 8) >> 3); r[p] = INV ? cmulc(r[p], pw[br]) : cmul(r[p], pw[br]); }
        if (INV) fft16<true>(r);
#pragma unroll
        for (int q = 0; q < 16; ++q) px[q * QS] = r[q];
    }
    __syncthreads();
}
template <bool INV> __device__ __forceinline__ void fft_pass4(float2* x, int tid) {
#pragma unroll 2
    for (int w = tid; w < 4096; w += 512) {
        float4* p = (float4*)(x + PADI(4 * w));
        const float4 v01 = p[0], v23 = p[1];
        const float2 r0 = make_float2(v01.x, v01.y), r1 = make_float2(v01.z, v01.w), r2 = make_float2(v23.x, v23.y), r3 = make_float2(v23.z, v23.w);
        if (!INV) {
            const float2 a0 = make_float2(r0.x + r2.x, r0.y + r2.y), a2 = make_float2(r0.x - r2.x, r0.y - r2.y), a1 = make_float2(r1.x + r3.x, r1.y + r3.y), d = make_float2(r1.x - r3.x, r1.y - r3.y);
            const float2 a3 = make_float2(d.y, -d.x);
            p[0] = make_float4(a0.x + a1.x, a0.y + a1.y, a0.x - a1.x, a0.y - a1.y); p[1] = make_float4(a2.x + a3.x, a2.y + a3.y, a2.x - a3.x, a2.y - a3.y);
        } else {
            const float2 a0 = make_float2(r0.x + r1.x, r0.y + r1.y), a1 = make_float2(r0.x - r1.x, r0.y - r1.y), a2 = make_float2(r2.x + r3.x, r2.y + r3.y), a3 = make_float2(r2.x - r3.x, r2.y - r3.y);
            const float2 b = make_float2(-a3.y, a3.x);
            p[0] = make_float4(a0.x + a2.x, a0.y + a2.y, a1.x + b.x, a1.y + b.y); p[1] = make_float4(a0.x - a2.x, a0.y - a2.y, a1.x - b.x, a1.y - b.y);
        }
    }
    __syncthreads();
}
__device__ __forceinline__ void fft_fwd(float2* x, const float2* twl, int tid) { fft_pass16<false, 10>(x, twl, tid); fft_pass16<false, 6>(x, twl, tid); fft_pass16<false, 2>(x, twl, tid); fft_pass4<false>(x, tid); }
__device__ __forceinline__ void fft_inv(float2* x, const float2* twl, int tid) { fft_pass4<true>(x, tid); fft_pass16<true, 2>(x, twl, tid); fft_pass16<true, 6>(x, twl, tid); fft_pass16<true, 10>(x, twl, tid); }
__device__ __forceinline__ void spec_mul(float2* x, const unsigned* __restrict__ sp, int tid) {
    for (int p = tid; p < NFFT; p += 512) { const unsigned w = sp[p]; const float kr = pg8::bfl(w), ki = pg8::bfh(w); const float2 a = x[PADI(p)]; x[PADI(p)] = make_float2(a.x * kr - a.y * ki, a.x * ki + a.y * kr); }
    __syncthreads();
}
__device__ __forceinline__ float hy_sc(const bf16* r, int t, float w0, float w1, float w2, float sb) {
    const float a = bf2f(r[max(t - 1, 0)]), b = bf2f(r[t]), c = bf2f(r[min(t + 1, L_SEQ - 1)]);
    return sb + w1 * b + (t > 0 ? w0 * a : 0.f) + (t < L_SEQ - 1 ? w2 * c : 0.f);
}
__device__ __forceinline__ float gelu_tanh(float x) { const float u = 0.7978845608028654f * (x + 0.044715f * x * x * x); return 0.5f * x * (1.f + tanhf(u)); }

enum { OP_CONVERT = 0, OP_F2, OP_F3, OP_GEMM_K, OP_GEMM_V, OP_GEMM_IN, OP_MIX1, OP_MIX2, OP_GEMM_GLU, OP_GEMM_OUT, OP_NORM_MIX, OP_GEMM_Q, OP_GEMM_S, OP_SOFTMAX, OP_GEMM_PV,
       OP_GEMM_O, OP_NORM_XA, OP_GEMM_UP, OP_GEMM_DOWN, OP_NORM_MLP, OP_COUNT };

__global__ void __launch_bounds__(512, 2) fwd_kernel(Args args) {
    extern __shared__ __attribute__((aligned(16))) unsigned char lds[];
    cg::grid_group grid = cg::this_grid();
#define GRID_SYNC() do { xcd_barrier(xbar); } while (0)
    { const int tid = threadIdx.x;
    if (tid < 37) ((unsigned long long*)(lds + TAB_OFF))[tid] = (unsigned long long)args.in[tid];
    if (tid == 37) ((unsigned long long*)(lds + TAB_OFF))[37] = (unsigned long long)args.out;
    if (tid == 38) ((unsigned long long*)(lds + TAB_OFF))[38] = (unsigned long long)args.ws;
      if (tid == 40 || tid == 41) ((unsigned*)(lds + TAB_OFF + 384))[tid - 40] = 0u; }
    __syncthreads();
    XcdBarrier xbar = xcd_barrier_post((unsigned*)(args.ws + WS_BAR), (volatile __attribute__((address_space(3))) unsigned*)(lds + TAB_OFF + 384));
    asm volatile("s_waitcnt vmcnt(0) lgkmcnt(0)" ::: "memory"); __syncthreads(); grid.sync();
#define INP(i) ((const float*)ldptr(lds, (i)))
    for (int layer_ = 0; layer_ < 4; ++layer_) {
#ifndef REPEAT_MASK
#define REPEAT_MASK 0u
#endif
        for (int opi = 0; opi < OP_COUNT * 2; ++opi) {
            const int op = opi >> 1;
            if ((opi & 1) && !((REPEAT_MASK >> op) & 1u)) continue;
            int tid = threadIdx.x; asm volatile("" : "+v"(tid));
            int bid = blockIdx.x; asm volatile("" : "+s"(bid));
            int G = gridDim.x; asm volatile("" : "+s"(G));
            int layer = layer_; asm volatile("" : "+s"(layer));
            const int lane = tid & 63, wave = __builtin_amdgcn_readfirstlane(tid >> 6);
            const int gw = bid * 8 + wave, NGW = G * 8, gt = bid * 512 + tid, GT = G * 512;
            const int jj = layer >> 1; const bool odd = (layer & 1) != 0;
            unsigned char* ws = (unsigned char*)ldptr(lds, 38);
            float* X = (float*)ldptr(lds, 37);
            float* KT0B = (float*)(ws + WS_KT0B); float2* TW = (float2*)(ws + WS_TW);
            float2* S5F = (float2*)(ws + WS_S5F); float* H2 = (float*)(ws + WS_H2);
            bf16* MN = (bf16*)(ws + WS_MN); bf16* KB = (bf16*)(ws + WS_KB); bf16* VT = (bf16*)(ws + WS_VT);
            unsigned char* WB = ws + WS_W;
            bf16* HN = (bf16*)(ws + WS_HN); bf16* MIXOUT = (bf16*)(ws + WS_MIXOUT); bf16* MIXIN = (bf16*)(ws + WS_MIXIN);
            unsigned char* R = ws + WS_R;

            bool do_sync = true;
            pg8::Gemm g{0, 0, 0}; pg8::Sched S{}; pg8::EpiRT E{}; bool is_gemm = false;
            S.G = G; S.c = bid; S.sa_n = 0; S.sb_b = 0;
            auto setg = [&](const void* A, int lda, const void* Bt, int ldb, int M, int N, int K) {
                g.K = K; g.lda = lda; g.ldb = ldb; S.nM = M / 256; S.nN = N / 256; S.nwg = S.nM * S.nN; S.A = (const char*)A; S.Bt = (const char*)Bt;
                S.sa_m = (size_t)256 * lda * 2; S.sb_n = (size_t)256 * ldb * 2; is_gemm = true; };
            switch (op) {
            case OP_GEMM_K: setg(MN, D, WB + W_K, D, NMEMT, D, D); E.mode = pg8::EP_BF16; E.O = KB; E.ldc = D; do_sync = false; break;
            case OP_GEMM_V: setg(MN, D, WB + W_V, D, NMEMT, D, D); E.mode = pg8::EP_VT; E.O = VT; do_sync = false; break;
            case OP_GEMM_IN: setg(HN, D, WB + W_IN, D, T_TOK, 2048, D);
                if (!odd) { E.mode = pg8::EP_BF16; E.O = R + R_P; E.ldc = 2048; } else { E.mode = pg8::EP_ODDIN; E.O = R + R_PS5; E.O2 = R + R_PT; } break;
            case OP_GEMM_GLU: if (odd) { setg(R + R_G, 512, WB + W_GLU, 512, T_TOK, 512, 512); E.mode = pg8::EP_GLU; E.O = MIXIN; E.ldc = D; E.aux = R + R_G; } break;
            case OP_GEMM_OUT: setg(MIXIN, D, WB + W_OUT, D, T_TOK, D, D); E.mode = pg8::EP_BF16; E.O = MIXOUT; E.ldc = D; break;
            case OP_GEMM_Q: setg(HN, D, WB + W_Q, D, T_TOK, D, D); E.mode = pg8::EP_BF16; E.O = R + R_Q; E.ldc = D; break;
            case OP_GEMM_S: setg(R + R_Q, D, KB, D, T_TOK, D, 256); S.sa_n = 512; S.sb_n = 512; S.sb_b = (size_t)256 * D * 2;
                E.mode = pg8::EP_F32S; E.O = R + R_SC; E.ldc = D; E.scale = 0.0625f; break;
            case OP_GEMM_PV: setg(R + R_PROB, D, VT, 256, T_TOK, D, 256); S.sa_n = 512; S.sb_n = (size_t)256 * 256 * 2; S.sb_b = (size_t)1024 * 256 * 2;
                E.mode = pg8::EP_BF16; E.O = R + R_Q; E.ldc = D; break;
            case OP_GEMM_O: setg(R + R_Q, D, WB + W_O, D, T_TOK, D, D); E.mode = pg8::EP_BF16; E.O = MIXOUT; E.ldc = D; break;
            case OP_GEMM_UP: setg(HN, D, WB + W_1, D, T_TOK, FF, D); E.mode = pg8::EP_RELU2; E.O = R + R_H; E.ldc = FF; break;
            case OP_GEMM_DOWN: setg(R + R_H, FF, WB + W_2, FF, T_TOK, D, FF); E.mode = pg8::EP_BF16; E.O = MIXOUT; E.ldc = D; break;
            default: break;
            }
            if (is_gemm) {
                pg8::gemm_phase<pg8::EpiRT, pg8::Sched, true, true>((PG8_LAS unsigned char*)lds, g, S, E, tid);
                __syncthreads();
                if (do_sync) GRID_SYNC();
                continue;
            }
            if (op == OP_CONVERT) {
                float* scr = (float*)(lds + wave * 16384);
                const float* Win = odd ? INP(17) + (size_t)jj * D * 2048 : INP(12) + (size_t)jj * D * 2048;
                const float* Wout = odd ? INP(36) + (size_t)jj * D * D : INP(16) + (size_t)jj * D * D;
                const int inc0 = odd ? 0 : 512;
                const int I_IN = (D / 64) * ((2048 - inc0) / 32), I_SQ = (D / 64) * (D / 32), I_1 = (D / 64) * (FF / 32), I_2 = (FF / 64) * (D / 32), I_GLU = odd ? (512 / 64) * (512 / 32) : 0;
                const int NIT = I_IN + 5 * I_SQ + I_1 + I_2 + I_GLU;
                for (int it = gw; it < NIT; it += NGW) {
                    int r = it;
                    if (r < I_IN) { transpose_item(Win + inc0, 2048, 2048 - inc0, (bf16*)(WB + W_IN) + (size_t)inc0 * D, D, scr, r, lane); continue; } r -= I_IN;
                    if (r < I_SQ) { transpose_item(Wout, D, D, (bf16*)(WB + W_OUT), D, scr, r, lane); continue; } r -= I_SQ;
                    if (r < I_SQ) { transpose_item(INP(6) + (size_t)layer * D * D, D, D, (bf16*)(WB + W_Q), D, scr, r, lane); continue; } r -= I_SQ;
                    if (r < I_SQ) { transpose_item(INP(7) + (size_t)layer * D * D, D, D, (bf16*)(WB + W_K), D, scr, r, lane); continue; } r -= I_SQ;
                    if (r < I_SQ) { transpose_item(INP(8) + (size_t)layer * D * D, D, D, (bf16*)(WB + W_V), D, scr, r, lane); continue; } r -= I_SQ;
                    if (r < I_SQ) { transpose_item(INP(9) + (size_t)layer * D * D, D, D, (bf16*)(WB + W_O), D, scr, r, lane); continue; } r -= I_SQ;
                    if (r < I_1) { transpose_item(INP(10) + (size_t)layer * D * FF, FF, FF, (bf16*)(WB + W_1), D, scr, r, lane); continue; } r -= I_1;
                    if (r < I_2) { transpose_item(INP(11) + (size_t)layer * FF * D, D, D, (bf16*)(WB + W_2), FF, scr, r, lane); continue; } r -= I_2;
                    transpose_item(INP(26) + (size_t)jj * 512 * 512, 512, 512, (bf16*)(WB + W_GLU), 512, scr, r, lane);
                }
                if (!odd) {
                    const float* Wg = INP(13) + (size_t)jj * 4 * 128 * 128; const float* psc = INP(14) + (size_t)jj * 512;
                    for (int o = gt; o < D * 512; o += GT) { const int k = o >> 9, n = o & 511, gq = n >> 7, d = n & 127;
                        const float* wr_ = Win + (size_t)k * 2048 + gq * 128; const float* wg = Wg + (size_t)gq * 128 * 128 + d; float acc = 0.f;
#pragma unroll 8
                        for (int c = 0; c < 128; ++c) acc += wr_[c] * wg[c * 128];
                        ((bf16*)(WB + W_IN))[(size_t)n * D + k] = (bf16)f2bf(acc * psc[n]); }
                }
                for (int m = gw; m < NMEMT; m += NGW) norm_row(INP(1) + (size_t)m * D, nullptr, nullptr, nullptr, INP(4) + (size_t)layer * D, MN + (size_t)m * D, lane);
                if (layer == 0) {
                    for (int m = gw; m < T_TOK; m += NGW) norm_row(INP(0) + (size_t)m * D, X + (size_t)m * D, nullptr, nullptr, INP(2), HN + (size_t)m * D, lane);
                    for (int k = gt; k < 8192; k += GT) { float sn, cs; sincospif((float)k * (2.0f / 16384.0f), &sn, &cs); TW[k] = make_float2(cs, -sn); }
                }
                if (odd) {
                    __syncthreads();
                    float* zs = (float*)lds; float* h1s = zs + 8 * 36;
                    const float* w1 = INP(29) + (size_t)jj * 33 * 64; const float* b1 = INP(30) + jj * 64; const float* w2 = INP(31) + (size_t)jj * 64 * 64; const float* b2 = INP(32) + jj * 64; const float* fr = INP(34) + jj * 64;
                    for (int tb = bid; tb < L_SEQ / 8; tb += G) {
                        __syncthreads();
                        if (tid < 8 * 33) { const int tl = tid / 33, k = tid % 33, t = tb * 8 + tl; float z;
                            if (k == 0) z = (float)t / (float)(L_SEQ - 1);
                            else { const int bnd = (k - 1) & 15; const float band = 1e-4f + (float)bnd * ((15.0f - 1e-4f) / 15.0f); const float ang = ((float)(2.0 * 3.14159265358979323846 / L_SEQ) * (float)t) * band;
                                z = (k <= 16) ? cosf(ang) : -sinf(ang); }
                            zs[tl * 36 + k] = z; }
                        __syncthreads();
                        const int tl = tid >> 6, j = tid & 63;
                        { float a = b1[j];
                            for (int k = 0; k < 33; ++k) a += zs[tl * 36 + k] * w1[k * 64 + j];
                            h1s[tl * 64 + j] = sinf(fr[j] * a); }
                        __syncthreads();
                        { float a = b2[j];
                            for (int k = 0; k < 64; ++k) a += h1s[tl * 64 + k] * w2[k * 64 + j];
                            H2[(size_t)(tb * 8 + tl) * 64 + j] = sinf(fr[j] * a); }
                    }
                }
            } else if (op == OP_F2) {
                if (!odd) continue;
                float* hs = (float*)lds; float* KT = (float*)(R + R_KT); float* PART = (float*)(ws + WS_PART);
                const float* w3 = INP(33) + (size_t)jj * 64 * 2048;
                for (int it = bid; it < 512; it += G) {
                    const int tt = it >> 2, cq = it & 3;
                    __syncthreads();
                    for (int e = tid; e < 64 * 64; e += 512) hs[(e >> 6) * 65 + (e & 63)] = H2[(size_t)tt * 4096 + e];
                    __syncthreads();
                    const int t = tt * 64 + lane; const float tn = (float)t / (float)(L_SEQ - 1);
                    for (int i = 0; i < 16; ++i) {
                        const int col = cq * 512 + wave * 64 + 4 * i;
                        float a0 = 0.f, a1 = 0.f, a2 = 0.f, a3 = 0.f;
#pragma unroll 8
                        for (int k = 0; k < 64; ++k) { const float h = hs[lane * 65 + k]; const f32x4 w = *(const f32x4*)(w3 + (size_t)k * 2048 + col); a0 += h * w.x; a1 += h * w.y; a2 += h * w.z; a3 += h * w.w; }
                        const int o = col >> 10, dir = (col >> 9) & 1, c0 = col & 511;
                        float av[4] = {a0, a1, a2, a3};
#pragma unroll
                        for (int e = 0; e < 4; ++e) { const int c = c0 + e;
                            const float lo_ = -4.605170185988091f / 1.5f, hi_ = -4.605170185988091f / 0.3f;
                            const float delta = fabsf(lo_ + (float)c * ((hi_ - lo_) / 511.0f));
                            const float v = av[e] * expf(-tn * delta);
                            const float sa = wave_sum(fabsf(v));
                            if (lane == 0) PART[(size_t)tt * 2048 + col + e] = sa;
                            float* kr = KT + (size_t)(o * 512 + c) * NFFT;
                            if (dir == 0) kr[t] = v; else if (t > 0) kr[NFFT - t] = v; else KT0B[o * 512 + c] = v; }
                    }
                }
            } else if (op == OP_F3) {
                if (!odd) continue;
                float2* x = (float2*)lds; const float* KT = (const float*)(R + R_KT); unsigned* SPEC = (unsigned*)(R + R_SPEC);
                float2* twl = (float2*)(lds + TWL_OFF);
                for (int k = tid; k < 1024; k += 512) twl[k] = TW[k];
                for (int f = bid; f < 1024; f += G) {
                    __syncthreads();
                    const float* kr = KT + (size_t)f * NFFT;
                    for (int p = tid; p < NFFT; p += 512) { float v = (p == L_SEQ) ? 0.f : kr[p]; if (p == 0) v += KT0B[f]; x[PADI(p)] = make_float2(v, 0.f); }
                    __syncthreads();
                    fft_fwd(x, twl, tid);
                    float nsum; { const float* PART = (const float*)(ws + WS_PART) + (size_t)(f >> 9) * 1024 + (f & 511);
                        nsum = (PART[(size_t)lane * 2048] + PART[(size_t)lane * 2048 + 512]) + (PART[(size_t)(lane + 64) * 2048] + PART[(size_t)(lane + 64) * 2048 + 512]); nsum = wave_sum(nsum); }
                    const float inv = 1.0f / ((nsum + 1e-6f) * (float)NFFT);
                    for (int p = tid; p < NFFT; p += 512) { const float2 a = x[PADI(p)]; SPEC[(size_t)f * NFFT + p] = pk2(a.x * inv, a.y * inv); }
                }
            } else if (op == OP_MIX1) {
                if (!odd) {
                    const bf16* P = (const bf16*)(R + R_P); const float* cw = INP(15) + (size_t)jj * 3 * 512;
                    for (int item = gt; item < T_TOK * 128; item += GT) {
                        const int row = item >> 7, c8 = item & 127, t = row & (L_SEQ - 1);
                        float o[8];
                        if (c8 < 64) {
                            const int c = c8 * 8, h = 1 << (c >> 7); const int lo = max(t - h, 0), hi = min(t + h, L_SEQ);
                            float s[8] = {0.f, 0.f, 0.f, 0.f, 0.f, 0.f, 0.f, 0.f};
                            const bf16* base = P + (size_t)(row - t) * 2048 + c;
                            for (int tau = lo; tau < hi; ++tau) { const u32x4 w = *(const u32x4*)(base + (size_t)tau * 2048);
                                s[0] += pg8::bfl(w.x); s[1] += pg8::bfh(w.x); s[2] += pg8::bfl(w.y); s[3] += pg8::bfh(w.y); s[4] += pg8::bfl(w.z); s[5] += pg8::bfh(w.z); s[6] += pg8::bfl(w.w); s[7] += pg8::bfh(w.w); }
                            const u32x4 w = *(const u32x4*)(base + (size_t)t * 2048); const float ic = 1.0f / (float)(hi - lo);
                            o[0] = s[0] * ic - pg8::bfl(w.x); o[1] = s[1] * ic - pg8::bfh(w.x); o[2] = s[2] * ic - pg8::bfl(w.y); o[3] = s[3] * ic - pg8::bfh(w.y);
                            o[4] = s[4] * ic - pg8::bfl(w.z); o[5] = s[5] * ic - pg8::bfh(w.z); o[6] = s[6] * ic - pg8::bfl(w.w); o[7] = s[7] * ic - pg8::bfh(w.w);
                        } else {
                            const int c = (c8 - 64) * 8; const bf16* pr = P + (size_t)row * 2048 + c;
                            float acc[8] = {0.f, 0.f, 0.f, 0.f, 0.f, 0.f, 0.f, 0.f};
#pragma unroll
                            for (int dt = -1; dt <= 1; ++dt) {
                                if (t + dt < 0 || t + dt >= L_SEQ) continue;
                                const u32x4 cg_ = *(const u32x4*)(pr + (ptrdiff_t)dt * 2048 + 1024), hv = *(const u32x4*)(pr + (ptrdiff_t)dt * 2048 + 1536);
                                const f32x4 wa = *(const f32x4*)(cw + (dt + 1) * 512 + c), wb = *(const f32x4*)(cw + (dt + 1) * 512 + c + 4);
                                acc[0] += wa.x * pg8::bfl(cg_.x) * pg8::bfl(hv.x); acc[1] += wa.y * pg8::bfh(cg_.x) * pg8::bfh(hv.x); acc[2] += wa.z * pg8::bfl(cg_.y) * pg8::bfl(hv.y); acc[3] += wa.w * pg8::bfh(cg_.y) * pg8::bfh(hv.y);
                                acc[4] += wb.x * pg8::bfl(cg_.z) * pg8::bfl(hv.z); acc[5] += wb.y * pg8::bfh(cg_.z) * pg8::bfh(hv.z); acc[6] += wb.z * pg8::bfl(cg_.w) * pg8::bfl(hv.w); acc[7] += wb.w * pg8::bfh(cg_.w) * pg8::bfh(hv.w);
                            }
                            const u32x4 bg = *(const u32x4*)(pr + 512);
                            o[0] = acc[0] * pg8::bfl(bg.x); o[1] = acc[1] * pg8::bfh(bg.x); o[2] = acc[2] * pg8::bfl(bg.y); o[3] = acc[3] * pg8::bfh(bg.y);
                            o[4] = acc[4] * pg8::bfl(bg.z); o[5] = acc[5] * pg8::bfh(bg.z); o[6] = acc[6] * pg8::bfl(bg.w); o[7] = acc[7] * pg8::bfh(bg.w);
                        }
                        u32x4 w; w.x = pk2(o[0], o[1]); w.y = pk2(o[2], o[3]); w.z = pk2(o[4], o[5]); w.w = pk2(o[6], o[7]);
                        *(u32x4*)(MIXIN + (size_t)row * D + c8 * 8) = w;
                    }
                } else {
                    const bf16* PS5 = (const bf16*)(R + R_PS5);
                    for (int bt = bid; bt < 256; bt += G) {
                        const int bgi = bt & 63, b = bgi >> 5, gq = bgi & 31, chunk = (bt >> 6) * 8 + wave, n = lane;
                        float br[16], bi[16];
                        { const float* pr = INP(21) + ((size_t)(jj * 32 + gq) * 64 + n) * 16; const float* pi = INP(22) + ((size_t)(jj * 32 + gq) * 64 + n) * 16;
#pragma unroll
                            for (int q = 0; q < 4; ++q) { const f32x4 a = *(const f32x4*)(pr + 4 * q), c = *(const f32x4*)(pi + 4 * q);
                                br[4 * q] = a.x; br[4 * q + 1] = a.y; br[4 * q + 2] = a.z; br[4 * q + 3] = a.w; bi[4 * q] = c.x; bi[4 * q + 1] = c.y; bi[4 * q + 2] = c.z; bi[4 * q + 3] = c.w; } }
                        for (int d = 0; d < 2; ++d) {
                            const size_t li = ((size_t)(jj * 2 + d) * 32 + gq) * 64 + n;
                            const float lr = fminf(INP(18)[li], -1e-4f), lim = INP(19)[li], dtv = expf(INP(20)[(jj * 2 + d) * 32 + gq]);
                            const float mag = expf(lr * dtv); float sn, cs; sincosf(lim * dtv, &sn, &cs); const float ar = mag * cs, ai = mag * sn;
                            float sr = 0.f, si = 0.f;
                            const bf16* ub = PS5 + ((size_t)b * L_SEQ + chunk * 256) * 512 + gq * 16;
#pragma unroll 4
                            for (int st = 0; st < 256; ++st) {
                                const int tl = d ? 255 - st : st;
                                const u32x4 u0 = *(const u32x4*)(ub + (size_t)tl * 512), u1 = *(const u32x4*)(ub + (size_t)tl * 512 + 8);
                                const float u[16] = {pg8::bfl(u0.x), pg8::bfh(u0.x), pg8::bfl(u0.y), pg8::bfh(u0.y), pg8::bfl(u0.z), pg8::bfh(u0.z), pg8::bfl(u0.w), pg8::bfh(u0.w),
                                                     pg8::bfl(u1.x), pg8::bfh(u1.x), pg8::bfl(u1.y), pg8::bfh(u1.y), pg8::bfl(u1.z), pg8::bfh(u1.z), pg8::bfl(u1.w), pg8::bfh(u1.w)};
                                float bur = 0.f, bui = 0.f;
#pragma unroll
                                for (int q = 0; q < 16; ++q) { bur += br[q] * u[q]; bui += bi[q] * u[q]; }
                                const float nr = ar * sr - ai * si + bur, ni = ar * si + ai * sr + bui; sr = nr; si = ni;
                            }
                            S5F[((((size_t)d * 2 + b) * 32 + gq) * 32 + chunk) * 64 + n] = make_float2(sr, si);
                        }
                    }
                    __syncthreads();
                    float2* x = (float2*)lds; const bf16* PT = (const bf16*)(R + R_PT); const unsigned* SPEC = (const unsigned*)(R + R_SPEC); bf16* YT = (bf16*)(R + R_YT);
                    const float* sw = INP(27) + (size_t)jj * 3 * 1536; const float* sbv = INP(28) + (size_t)jj * 1536; const float* hb = INP(35) + (size_t)jj * 2 * 512;
                    float2* twl = (float2*)(lds + TWL_OFF);
                    for (int k = tid; k < 1024; k += 512) twl[k] = TW[k];
                    for (int c = bid; c < 512; c += G) {
                        int tid_h = threadIdx.x; asm volatile("" : "+v"(tid_h));
                        const bf16* r_go = PT + (size_t)c * T_TOK; const bf16* r_gm = PT + (size_t)(512 + c) * T_TOK; const bf16* r_v = PT + (size_t)(1024 + c) * T_TOK;
                        const float go0 = sw[c], go1 = sw[1536 + c], go2 = sw[3072 + c], gob = sbv[c];
                        const float gm0 = sw[512 + c], gm1 = sw[1536 + 512 + c], gm2 = sw[3072 + 512 + c], gmb = sbv[512 + c];
                        const float v0 = sw[1024 + c], v1 = sw[1536 + 1024 + c], v2 = sw[3072 + 1024 + c], vb = sbv[1024 + c];
                        const float bias0 = hb[c], bias1 = hb[512 + c];
                        __syncthreads();
                        for (int t = tid_h; t < L_SEQ; t += 512) { x[PADI(t)] = make_float2(hy_sc(r_v, t, v0, v1, v2, vb), hy_sc(r_v + L_SEQ, t, v0, v1, v2, vb)); x[PADI(L_SEQ) + PADI(t)] = make_float2(0.f, 0.f); }
                        __syncthreads();
                        fft_fwd(x, twl, tid); spec_mul(x, SPEC + (size_t)c * NFFT, tid); fft_inv(x, twl, tid);
                        float2 zr[16];
#pragma unroll
                        for (int i = 0; i < 16; ++i) { const int t = tid_h + 512 * i; const float2 y1 = x[PADI(t)];
                            const float va = hy_sc(r_v, t, v0, v1, v2, vb), vbb = hy_sc(r_v + L_SEQ, t, v0, v1, v2, vb);
                            const float ga = hy_sc(r_gm, t, gm0, gm1, gm2, gmb), gb = hy_sc(r_gm + L_SEQ, t, gm0, gm1, gm2, gmb);
                            zr[i] = make_float2(ga * (y1.x + va * bias0), gb * (y1.y + vbb * bias0));
                            x[PADI(t)] = zr[i]; x[PADI(L_SEQ) + PADI(t)] = make_float2(0.f, 0.f); }
                        __syncthreads();
                        fft_fwd(x, twl, tid); spec_mul(x, SPEC + (size_t)(512 + c) * NFFT, tid); fft_inv(x, twl, tid);
#pragma unroll
                        for (int i = 0; i < 16; ++i) { const int t = tid_h + 512 * i; const float2 y2 = x[PADI(t)];
                            const float ga = hy_sc(r_go, t, go0, go1, go2, gob), gb = hy_sc(r_go + L_SEQ, t, go0, go1, go2, gob);
                            YT[(size_t)c * T_TOK + t] = (bf16)f2bf(ga * (y2.x + zr[i].x * bias1));
                            YT[(size_t)c * T_TOK + L_SEQ + t] = (bf16)f2bf(gb * (y2.y + zr[i].y * bias1)); }
                    }
                }
            } else if (op == OP_MIX2) {
                if (!odd) continue;
                const bf16* PS5 = (const bf16*)(R + R_PS5); float* Y = (float*)(R + R_Y); bf16* Gb = (bf16*)(R + R_G);
                float2* CL = (float2*)lds; float2* tile = (float2*)(lds + 16384) + wave * (16 * 65);
                for (int bt = bid; bt < 256; bt += G) {
                    const int bgi = bt & 63, b = bgi >> 5, gq = bgi & 31, chunk = (bt >> 6) * 8 + wave, n = lane;
                    __syncthreads();
                    for (int e = tid; e < 2048; e += 512) { const int d = e >> 10, nn = (e >> 4) & 63, h = e & 15;
                        const size_t li = ((size_t)(jj * 2 + d) * 32 + gq) * 64 + nn;
                        const float lr = fminf(INP(18)[li], -1e-4f), lim = INP(19)[li], dtv = expf(INP(20)[(jj * 2 + d) * 32 + gq]);
                        const float mag = expf(lr * dtv); float sn, cs; sincosf(lim * dtv, &sn, &cs); const float ar = mag * cs - 1.f, ai = mag * sn;
                        const float den = 1.f / (lr * lr + lim * lim); const float cr = (ar * lr + ai * lim) * den, ci = (ai * lr - ar * lim) * den;
                        const size_t cidx = (((size_t)(jj * 2 + d) * 32 + gq) * 16 + h) * 64 + nn; const float xr = INP(23)[cidx], xi = INP(24)[cidx];
                        CL[e] = make_float2(xr * cr - xi * ci, xr * ci + xi * cr); }
                    __syncthreads();
                    float br[16], bi[16];
                    { const float* pr = INP(21) + ((size_t)(jj * 32 + gq) * 64 + n) * 16; const float* pi = INP(22) + ((size_t)(jj * 32 + gq) * 64 + n) * 16;
#pragma unroll
                        for (int q = 0; q < 4; ++q) { const f32x4 a = *(const f32x4*)(pr + 4 * q), c = *(const f32x4*)(pi + 4 * q);
                            br[4 * q] = a.x; br[4 * q + 1] = a.y; br[4 * q + 2] = a.z; br[4 * q + 3] = a.w; bi[4 * q] = c.x; bi[4 * q + 1] = c.y; bi[4 * q + 2] = c.z; bi[4 * q + 3] = c.w; } }
                    const int tl16 = lane & 15, hq = lane >> 4;
                    const f32x4 dsk = *(const f32x4*)(INP(25) + (size_t)jj * 512 + gq * 16 + 4 * hq);
                    for (int d = 0; d < 2; ++d) {
                        if (d) { __threadfence_block(); asm volatile("s_waitcnt vmcnt(0)" ::: "memory"); }
                        const size_t li = ((size_t)(jj * 2 + d) * 32 + gq) * 64 + n;
                        const float lr = fminf(INP(18)[li], -1e-4f), lim = INP(19)[li], dtv = expf(INP(20)[(jj * 2 + d) * 32 + gq]);
                        const float mag = expf(lr * dtv); float sn, cs; sincosf(lim * dtv, &sn, &cs); const float ar = mag * cs, ai = mag * sn;
                        float pr_ = ar, pi_ = ai;
#pragma unroll
                        for (int q = 0; q < 8; ++q) { const float t0 = pr_ * pr_ - pi_ * pi_, t1 = 2.f * pr_ * pi_; pr_ = t0; pi_ = t1; }
                        float sr = 0.f, si = 0.f;
                        const float2* Fb = S5F + ((((size_t)d * 2 + b) * 32 + gq) * 32) * 64 + n;
                        if (d == 0) { for (int cc = 0; cc < chunk; ++cc) { const float2 f = Fb[(size_t)cc * 64]; const float nr = pr_ * sr - pi_ * si + f.x, ni = pr_ * si + pi_ * sr + f.y; sr = nr; si = ni; } }
                        else { for (int cc = 31; cc > chunk; --cc) { const float2 f = Fb[(size_t)cc * 64]; const float nr = pr_ * sr - pi_ * si + f.x, ni = pr_ * si + pi_ * sr + f.y; sr = nr; si = ni; } }
                        const size_t rowc = (size_t)b * L_SEQ + chunk * 256;
                        const bf16* ub = PS5 + rowc * 512 + gq * 16;
                        const float2* CLd = CL + d * 1024;
                        for (int sc = 0; sc < 16; ++sc) {
#pragma unroll 4
                            for (int i = 0; i < 16; ++i) {
                                const int st = sc * 16 + i, tl = d ? 255 - st : st;
                                const u32x4 u0 = *(const u32x4*)(ub + (size_t)tl * 512), u1 = *(const u32x4*)(ub + (size_t)tl * 512 + 8);
                                const float u[16] = {pg8::bfl(u0.x), pg8::bfh(u0.x), pg8::bfl(u0.y), pg8::bfh(u0.y), pg8::bfl(u0.z), pg8::bfh(u0.z), pg8::bfl(u0.w), pg8::bfh(u0.w),
                                                     pg8::bfl(u1.x), pg8::bfh(u1.x), pg8::bfl(u1.y), pg8::bfh(u1.y), pg8::bfl(u1.z), pg8::bfh(u1.z), pg8::bfl(u1.w), pg8::bfh(u1.w)};
                                float bur = 0.f, bui = 0.f;
#pragma unroll
                                for (int q = 0; q < 16; ++q) { bur += br[q] * u[q]; bui += bi[q] * u[q]; }
                                const float nr = ar * sr - ai * si + bur, ni = ar * si + ai * sr + bui; sr = nr; si = ni;
                                tile[i * 65 + n] = make_float2(sr, si);
                            }
                            LDS_FENCE();
                            float a0 = 0.f, a1 = 0.f, a2 = 0.f, a3 = 0.f;
#pragma unroll 8
                            for (int nn = 0; nn < 64; ++nn) { const float2 s = tile[tl16 * 65 + nn]; const f32x4 c01 = *(const f32x4*)(CLd + nn * 16 + 4 * hq), c23 = *(const f32x4*)(CLd + nn * 16 + 4 * hq + 2);
                                a0 += c01.x * s.x - c01.y * s.y; a1 += c01.z * s.x - c01.w * s.y; a2 += c23.x * s.x - c23.y * s.y; a3 += c23.z * s.x - c23.w * s.y; }
                            LDS_FENCE();
                            const int st = sc * 16 + tl16, tl = d ? 255 - st : st; const size_t row = rowc + tl;
                            float* yp = Y + row * 512 + gq * 16 + 4 * hq;
                            if (d == 0) { *(f32x4*)yp = (f32x4){a0, a1, a2, a3}; }
                            else { const f32x4 yf = *(const f32x4*)yp; const u32x2 uw = *(const u32x2*)(PS5 + row * 512 + gq * 16 + 4 * hq);
                                const float y0 = yf.x + a0 + dsk.x * pg8::bfl(uw.x), y1 = yf.y + a1 + dsk.y * pg8::bfh(uw.x), y2 = yf.z + a2 + dsk.z * pg8::bfl(uw.y), y3 = yf.w + a3 + dsk.w * pg8::bfh(uw.y);
                                u32x2 w; w.x = pk2(gelu_tanh(y0), gelu_tanh(y1)); w.y = pk2(gelu_tanh(y2), gelu_tanh(y3));
                                *(u32x2*)(Gb + row * 512 + gq * 16 + 4 * hq) = w; }
                        }
                    }
                }
                __syncthreads();
                { bf16* ts = (bf16*)lds + wave * (64 * 66); const bf16* YT = (const bf16*)(R + R_YT);
                  for (int it = gw; it < 8 * 256; it += NGW) { const int cb = it & 7, tb = it >> 3;
                      for (int cl = 0; cl < 64; ++cl) ts[cl * 66 + lane] = YT[(size_t)(cb * 64 + cl) * T_TOK + tb * 64 + lane];
                      LDS_FENCE();
                      for (int tl = 0; tl < 64; ++tl) MIXIN[(size_t)(tb * 64 + tl) * D + 512 + cb * 64 + lane] = ts[lane * 66 + tl];
                      LDS_FENCE(); } }
            } else if (op == OP_SOFTMAX) {
                const float* SC = (const float*)(R + R_SC); bf16* PR = (bf16*)(R + R_PROB);
                for (int it = gw; it < T_TOK * 4; it += NGW) {
                    const f32x4 s = *((const f32x4*)(SC + (size_t)it * 256) + lane);
                    const float m = wave_max(fmaxf(fmaxf(s.x, s.y), fmaxf(s.z, s.w)));
                    const float e0 = __expf(s.x - m), e1 = __expf(s.y - m), e2 = __expf(s.z - m), e3 = __expf(s.w - m);
                    const float inv = 1.f / wave_sum((e0 + e1) + (e2 + e3));
                    u32x2 w; w.x = pk2(e0 * inv, e1 * inv); w.y = pk2(e2 * inv, e3 * inv);
                    *((u32x2*)(PR + (size_t)it * 256) + lane) = w;
                }
            } else if (op == OP_NORM_MIX || op == OP_NORM_XA || op == OP_NORM_MLP) {
                const float* gpost = (op == OP_NORM_MIX) ? INP(2) + (size_t)(layer * 2 + 1) * D : (op == OP_NORM_XA) ? INP(3) + (size_t)(layer * 2 + 1) * D : INP(5) + (size_t)(layer * 2 + 1) * D;
                const float* gpre = (op == OP_NORM_MIX) ? INP(3) + (size_t)(layer * 2) * D : (op == OP_NORM_XA) ? INP(5) + (size_t)(layer * 2) * D : INP(2) + (size_t)((layer + 1) * 2) * D;
                const bool want_hn = !(op == OP_NORM_MLP && layer == 3);
                for (int m = gw; m < T_TOK; m += NGW) norm_row(X + (size_t)m * D, X + (size_t)m * D, MIXOUT + (size_t)m * D, gpost, gpre, want_hn ? HN + (size_t)m * D : nullptr, lane);
            } else { continue; }
            GRID_SYNC();
        }
    }
}

extern "C" void kernel_launch(void* const* d_in, const int* in_sizes, int n_in, void* d_out, int out_size, void* d_ws, size_t ws_size, hipStream_t stream) {
    static int grid = 0;
    if (grid == 0) {
        if (n_in != 37 || out_size != T_TOK * D || ws_size < WS_END) { fprintf(stderr, "kernel_launch: unexpected shapes (n_in %d out %d ws %zu, need ws >= %zu)\n", n_in, out_size, ws_size, (size_t)WS_END); grid = -1; return; }
        int dev = 0, cus = 0, per_cu = 0;
        (void)hipGetDevice(&dev);
        (void)hipDeviceGetAttribute(&cus, hipDeviceAttributeMultiprocessorCount, dev);
        (void)hipFuncSetAttribute((const void*)fwd_kernel, hipFuncAttributeMaxDynamicSharedMemorySize, LDS_BYTES);
        (void)hipOccupancyMaxActiveBlocksPerMultiprocessor(&per_cu, (const void*)fwd_kernel, 512, LDS_BYTES);
        (void)hipGetLastError();
        grid = cus > 0 ? cus : 256;
        fprintf(stderr, "kernel_launch: grid %d (per_cu %d) ws %zu\n", grid, per_cu, ws_size);
    }
    if (grid < 0) return;
    if (hipMemsetAsync((char*)d_ws + WS_BAR, 0, WS_BAR_BYTES, stream) != hipSuccess) { fprintf(stderr, "kernel_launch: memset failed\n"); return; }
    Args a{};
    for (int i = 0; i < 37; ++i) a.in[i] = (const float*)d_in[i];
    a.out = (float*)d_out; a.ws = (unsigned char*)d_ws;
    void* kargs[] = {&a};
    hipError_t e = hipLaunchCooperativeKernel((void*)fwd_kernel, dim3(grid), dim3(512), kargs, LDS_BYTES, stream);
    if (e != hipSuccess) fprintf(stderr, "kernel_launch: cooperative launch failed: %s\n", hipGetErrorString(e));
}
```

```cpp
#include <hip/hip_runtime.h>
#include <hip/hip_cooperative_groups.h>
#include <cstdio>
#include <cstdint>
namespace cg = cooperative_groups;

namespace pg8 {
#define PG8_LAS __attribute__((address_space(3)))
typedef unsigned short bf16_t;
typedef short bf16x8 __attribute__((ext_vector_type(8)));
typedef float f32x4 __attribute__((ext_vector_type(4)));
typedef unsigned u32x4 __attribute__((ext_vector_type(4)));
constexpr int BM = 256, BK = 64, HALF = 128, HTB = HALF * BK * 2  , STAGE_BYTES = 8 * HTB, NXCD = 8, WGM = 8;

__host__ __device__ __forceinline__ int lds_byte(int r, int c) { const int st = (r >> 4) * 2 + (c >> 5), rr = r & 15, cc = c & 31, ob = rr * 64 + cc * 2; return st * 1024 + (ob ^ (((ob >> 9) & 1) << 5)); }
__host__ __device__ __forceinline__ void stage_rc(int b, int& R, int& C) { const int st = b / 1024, sb = b % 1024, swz = sb ^ (((sb >> 9) & 1) << 5); R = (st >> 1) * 16 + swz / 64; C = (st & 1) * 32 + (swz % 64) / 2; }
__host__ __device__ __forceinline__ int perm32(int rho) { const int n = rho >> 4, i = rho & 15; return 8 * (i >> 2) + 4 * n + (i & 3); }

struct Unit { int pm, pn; const char* a; const char* b; };
struct Gemm { int K, lda, ldb; };

struct Sched {
    int nM, nN, nwg, G, c; const char* A; const char* Bt; size_t sa_m, sa_n, sb_n, sb_b;
    __device__ __forceinline__ bool next(int i, Unit& u) const {
        const long L = (long)i * G + c; if (L >= nwg) return false;
        int wgid = (int)L; { const int q = nwg / NXCD, r = nwg % NXCD, xcd = wgid % NXCD, off = wgid / NXCD; wgid = (xcd < r ? xcd * (q + 1) : r * (q + 1) + (xcd - r) * q) + off; }
        const int nig = WGM * nN, gid = wgid / nig, fm = gid * WGM, gsz = (nM - fm) < WGM ? (nM - fm) : WGM;
        u.pm = fm + ((wgid % nig) % gsz); u.pn = (wgid % nig) / gsz;
        u.a = A + (size_t)u.pm * sa_m + (size_t)u.pn * sa_n; u.b = Bt + (size_t)u.pn * sb_n + (size_t)(u.pm >> 5) * sb_b; return true;
    }
    __device__ __forceinline__ void a_ready(const Unit&) const {}
    __device__ __forceinline__ void done(const Unit&) const {}
};

__device__ __forceinline__ unsigned cvt_pk_bf16(float lo, float hi) { unsigned r; asm volatile("v_cvt_pk_bf16_f32 %0, %1, %2" : "=v"(r) : "v"(lo), "v"(hi)); return r; }
__device__ __forceinline__ float bfl(unsigned w) { return __uint_as_float(w << 16); }
__device__ __forceinline__ float bfh(unsigned w) { return __uint_as_float(w & 0xffff0000u); }

enum { EP_BF16 = 0, EP_RELU2 = 1, EP_F32S = 2, EP_ODDIN = 3, EP_VT = 4, EP_GLU = 5 };
struct EpiRT {
    static constexpr bool PERM = true, AFTER_DRAIN = false;
    int mode; void* O; void* O2; const void* aux; int ldc; float scale;
    __device__ __forceinline__ void operator()(const f32x4 (&acc)[2][2][4][2], const Unit& u, int wr, int wc, int fr, int fq) const {
#pragma unroll
        for (int ai = 0; ai < 2; ++ai)
#pragma unroll
            for (int m = 0; m < 4; ++m) {
                const int row = u.pm * BM + ai * HALF + wr * 64 + m * 16 + fr;
#pragma unroll
                for (int bj = 0; bj < 2; ++bj) {
                    const int col = u.pn * BM + bj * HALF + wc * 32 + 8 * fq;
                    f32x4 v0 = acc[ai][bj][m][0], v1 = acc[ai][bj][m][1];
                    if (mode == EP_BF16) {
                        u32x4 w; w.x = cvt_pk_bf16(v0[0], v0[1]); w.y = cvt_pk_bf16(v0[2], v0[3]); w.z = cvt_pk_bf16(v1[0], v1[1]); w.w = cvt_pk_bf16(v1[2], v1[3]);
                        *(u32x4*)((bf16_t*)O + (size_t)row * ldc + col) = w;
                    } else if (mode == EP_RELU2) {
#pragma unroll
                        for (int e = 0; e < 4; ++e) { float a = fmaxf(v0[e], 0.f), b = fmaxf(v1[e], 0.f); v0[e] = a * a; v1[e] = b * b; }
                        u32x4 w; w.x = cvt_pk_bf16(v0[0], v0[1]); w.y = cvt_pk_bf16(v0[2], v0[3]); w.z = cvt_pk_bf16(v1[0], v1[1]); w.w = cvt_pk_bf16(v1[2], v1[3]);
                        *(u32x4*)((bf16_t*)O + (size_t)row * ldc + col) = w;
                    } else if (mode == EP_F32S) {
                        float* o = (float*)O + (size_t)row * ldc + col;
                        *(f32x4*)o = v0 * scale; *(f32x4*)(o + 4) = v1 * scale;
                    } else if (mode == EP_ODDIN) {
                        if (col < 512) {
                            u32x4 w; w.x = cvt_pk_bf16(v0[0], v0[1]); w.y = cvt_pk_bf16(v0[2], v0[3]); w.z = cvt_pk_bf16(v1[0], v1[1]); w.w = cvt_pk_bf16(v1[2], v1[3]);
                            *(u32x4*)((bf16_t*)O + (size_t)row * 512 + col) = w;
                        } else {
                            bf16_t* pt = (bf16_t*)O2 + (size_t)(col - 512) * 16384 + row;
#pragma unroll
                            for (int e = 0; e < 4; ++e) { pt[(size_t)e * 16384] = (bf16_t)(cvt_pk_bf16(v0[e], 0.f) & 0xffffu); pt[(size_t)(e + 4) * 16384] = (bf16_t)(cvt_pk_bf16(v1[e], 0.f) & 0xffffu); }
                        }
                    } else if (mode == EP_VT) {
                        bf16_t* vt = (bf16_t*)O + ((size_t)(row >> 8) * 1024 + col) * 256 + (row & 255);
#pragma unroll
                        for (int e = 0; e < 4; ++e) { vt[(size_t)e * 256] = (bf16_t)(cvt_pk_bf16(v0[e], 0.f) & 0xffffu); vt[(size_t)(e + 4) * 256] = (bf16_t)(cvt_pk_bf16(v1[e], 0.f) & 0xffffu); }
                    } else {
                        const u32x4 gw = *(const u32x4*)((const bf16_t*)aux + (size_t)row * 512 + col);
                        float g[8] = {bfl(gw.x), bfh(gw.x), bfl(gw.y), bfh(gw.y), bfl(gw.z), bfh(gw.z), bfl(gw.w), bfh(gw.w)};
                        float o[8];
#pragma unroll
                        for (int e = 0; e < 4; ++e) { o[e] = g[e] / (1.f + __expf(-v0[e])); o[e + 4] = g[e + 4] / (1.f + __expf(-v1[e])); }
                        u32x4 w; w.x = cvt_pk_bf16(o[0], o[1]); w.y = cvt_pk_bf16(o[2], o[3]); w.z = cvt_pk_bf16(o[4], o[5]); w.w = cvt_pk_bf16(o[6], o[7]);
                        *(u32x4*)((bf16_t*)O + (size_t)row * ldc + col) = w;
                    }
                }
            }
    }
};
template <class Epi, class Sched, bool ALIGN_EPI = false, bool SP2 = false>
__device__ __forceinline__ void gemm_phase(PG8_LAS unsigned char* lds, const Gemm g, const Sched& S, const Epi& E, const int tid) {
    const int wid = __builtin_amdgcn_readfirstlane(tid >> 6), lane = tid & 63, wr = wid >> 2, wc = wid & 3, fr = lane & 15, fq = lane >> 4;
    const int K = g.K, nt = K / BK;
    unsigned voffA[2], voffB[2];
#pragma unroll
    for (int i = 0; i < 2; ++i) { int R, C; stage_rc(tid * 16 + i * 8192, R, C); const int Rb = Epi::PERM ? ((R & ~31) + perm32(R & 31)) : R;
        voffA[i] = (unsigned)(R * g.lda + C) * 2u; voffB[i] = (unsigned)(Rb * g.ldb + C) * 2u; }
    const size_t kstep = (size_t)(BK * 2);
    const size_t hstepA = (size_t)HALF * g.lda * 2, hstepB = (size_t)HALF * g.ldb * 2;
    const unsigned ldsw = (unsigned)wid * 1024u;
    const int aoff = lds_byte(wr * 64 + fr, fq * 8), boff = lds_byte(wc * 32 + fr, fq * 8);
#define PG8_SA(b, h) (((b) * 2 + (h)) * HTB)
#define PG8_SB(b, h) ((4 + (b) * 2 + (h)) * HTB)
#define PG8_STAGE(bufoff, gbase, voff) do { _Pragma("unroll") for (int _i = 0; _i < 2; ++_i) \
        __builtin_amdgcn_global_load_lds((const unsigned*)((const char*)(gbase) + (voff)[_i]), (PG8_LAS unsigned*)(lds + (bufoff) + ldsw + _i * 8192), 16, 0, 0); } while (0)
#define PG8_LDA(dst, b, h) do { _Pragma("unroll") for (int m = 0; m < 4; ++m) _Pragma("unroll") for (int k = 0; k < 2; ++k) dst[m][k] = *(const PG8_LAS bf16x8*)(lds + PG8_SA(b, h) + aoff + m * 2048 + k * 1024); } while (0)
#define PG8_LDB(dst, b, h) do { _Pragma("unroll") for (int n = 0; n < 2; ++n) _Pragma("unroll") for (int k = 0; k < 2; ++k) dst[n][k] = *(const PG8_LAS bf16x8*)(lds + PG8_SB(b, h) + boff + n * 2048 + k * 1024); } while (0)
#define PG8_MMA(ai, bj, At, Bt) do { __builtin_amdgcn_s_setprio(1); _Pragma("unroll") for (int m = 0; m < 4; ++m) _Pragma("unroll") for (int n = 0; n < 2; ++n) _Pragma("unroll") for (int k = 0; k < 2; ++k) \
        acc[ai][bj][m][n] = __builtin_amdgcn_mfma_f32_16x16x32_bf16(Bt[n][k], At[m][k], acc[ai][bj][m][n], 0, 0, 0); __builtin_amdgcn_s_setprio(0); } while (0)
#define PG8_WAIT_V(n) asm volatile("s_waitcnt vmcnt(" #n ")" ::: "memory")
#define PG8_WAIT_L(n) asm volatile("s_waitcnt lgkmcnt(" #n ")" ::: "memory")
#define PG8_BAR __builtin_amdgcn_s_barrier()
#define PG8_SCHED __builtin_amdgcn_sched_barrier(0)
    Unit cur, nxt; int ui = 0;
    if (!S.next(0, cur)) return;
    f32x4 acc[2][2][4][2];
#pragma unroll
    for (int a = 0; a < 2; ++a)
#pragma unroll
        for (int b = 0; b < 2; ++b)
#pragma unroll
            for (int m = 0; m < 4; ++m)
#pragma unroll
                for (int n = 0; n < 2; ++n) acc[a][b][m][n] = (f32x4){0.f, 0.f, 0.f, 0.f};
    bf16x8 At[4][2], B0[2][2], B1[2][2];
    const char* cA = cur.a; const char* cB = cur.b;
    S.a_ready(cur);
    if constexpr (SP2) {
        PG8_STAGE(PG8_SB(0, 0), cB, voffB); PG8_STAGE(PG8_SB(0, 1), cB + hstepB, voffB); PG8_STAGE(PG8_SA(0, 0), cA, voffA); PG8_STAGE(PG8_SA(0, 1), cA + hstepA, voffA);
        if (wr == 1) PG8_BAR;
        PG8_WAIT_V(2); PG8_BAR;
        PG8_STAGE(PG8_SB(1, 0), cB + kstep, voffB); PG8_STAGE(PG8_SA(1, 0), cA + kstep, voffA); PG8_STAGE(PG8_SB(1, 1), cB + hstepB + kstep, voffB);
        PG8_WAIT_V(6); PG8_BAR;
    } else {
        PG8_STAGE(PG8_SB(0, 0), cB, voffB); PG8_STAGE(PG8_SA(0, 0), cA, voffA); PG8_STAGE(PG8_SB(0, 1), cB + hstepB, voffB); PG8_STAGE(PG8_SA(0, 1), cA + hstepA, voffA);
        if (wr == 1) PG8_BAR;
        PG8_WAIT_V(4); PG8_BAR;
        PG8_STAGE(PG8_SB(1, 0), cB + kstep, voffB); PG8_STAGE(PG8_SA(1, 0), cA + kstep, voffA); PG8_STAGE(PG8_SB(1, 1), cB + hstepB + kstep, voffB);
        PG8_WAIT_V(6); PG8_BAR;
    }
    for (;;) {
        const bool has_next = S.next(ui + 1, nxt);
        const char* nA = has_next ? nxt.a : cA; const char* nB = has_next ? nxt.b : cB;
        for (int t = 0; t < nt; t += 2) {
            const bool last = (t == nt - 2);
            const char* a1 = cA + (size_t)(t + 1) * kstep;
            const char* a2 = last ? nA : cA + (size_t)(t + 2) * kstep; const char* b2 = last ? nB : cB + (size_t)(t + 2) * kstep;
            const char* a3 = a2 + kstep; const char* b3 = b2 + kstep;
            if (last && has_next) S.a_ready(nxt);
            if constexpr (SP2) {
            PG8_LDB(B0, 0, 0); PG8_LDB(B1, 0, 1); PG8_SCHED; PG8_LDA(At, 0, 0); PG8_STAGE(PG8_SA(1, 1), a1 + hstepA, voffA);
            PG8_WAIT_V(8); PG8_WAIT_L(0); PG8_BAR; PG8_MMA(0, 0, At, B0); PG8_MMA(0, 1, At, B1); PG8_BAR; PG8_SCHED;
            PG8_LDA(At, 0, 1); PG8_STAGE(PG8_SB(0, 0), b2, voffB); PG8_STAGE(PG8_SB(0, 1), b2 + hstepB, voffB); PG8_STAGE(PG8_SA(0, 0), a2, voffA);
            PG8_WAIT_V(8); PG8_WAIT_L(0); PG8_BAR; PG8_MMA(1, 0, At, B0); PG8_MMA(1, 1, At, B1); PG8_BAR; PG8_SCHED;
            PG8_LDB(B0, 1, 0); PG8_LDB(B1, 1, 1); PG8_SCHED; PG8_LDA(At, 1, 0); PG8_STAGE(PG8_SA(0, 1), a2 + hstepA, voffA);
            PG8_WAIT_V(8); PG8_WAIT_L(0); PG8_BAR; PG8_MMA(0, 0, At, B0); PG8_MMA(0, 1, At, B1); PG8_BAR; PG8_SCHED;
            PG8_LDA(At, 1, 1); PG8_STAGE(PG8_SB(1, 0), b3, voffB); PG8_STAGE(PG8_SB(1, 1), b3 + hstepB, voffB); PG8_STAGE(PG8_SA(1, 0), a3, voffA);
            PG8_WAIT_V(8); PG8_WAIT_L(0); PG8_BAR; PG8_MMA(1, 0, At, B0); PG8_MMA(1, 1, At, B1); PG8_BAR; PG8_SCHED;
            } else {
            PG8_LDB(B0, 0, 0); PG8_SCHED; PG8_LDA(At, 0, 0); PG8_STAGE(PG8_SA(1, 1), a1 + hstepA, voffA);
            PG8_WAIT_L(8); PG8_BAR; PG8_WAIT_L(0); PG8_MMA(0, 0, At, B0); PG8_BAR; PG8_SCHED;
            PG8_LDB(B1, 0, 1); PG8_STAGE(PG8_SB(0, 0), b2, voffB);
            PG8_BAR; PG8_WAIT_L(0); PG8_MMA(0, 1, At, B1); PG8_BAR;
            PG8_LDA(At, 0, 1); PG8_STAGE(PG8_SA(0, 0), a2, voffA);
            PG8_BAR; PG8_WAIT_L(0); PG8_MMA(1, 0, At, B0); PG8_BAR; PG8_SCHED;
            PG8_STAGE(PG8_SB(0, 1), b2 + hstepB, voffB);
            PG8_WAIT_V(6); PG8_BAR; PG8_MMA(1, 1, At, B1); PG8_BAR;
            PG8_LDB(B0, 1, 0); PG8_SCHED; PG8_LDA(At, 1, 0); PG8_STAGE(PG8_SA(0, 1), a2 + hstepA, voffA);
            PG8_WAIT_L(8); PG8_BAR; PG8_WAIT_L(0); PG8_MMA(0, 0, At, B0); PG8_BAR; PG8_SCHED;
            PG8_LDB(B1, 1, 1); PG8_STAGE(PG8_SB(1, 0), b3, voffB);
            PG8_BAR; PG8_WAIT_L(0); PG8_MMA(0, 1, At, B1); PG8_BAR;
            PG8_LDA(At, 1, 1); PG8_STAGE(PG8_SA(1, 0), a3, voffA);
            PG8_BAR; PG8_WAIT_L(0); PG8_MMA(1, 0, At, B0); PG8_BAR; PG8_SCHED;
            PG8_STAGE(PG8_SB(1, 1), b3 + hstepB, voffB);
            PG8_WAIT_V(6); PG8_BAR; PG8_MMA(1, 1, At, B1); PG8_BAR;
            }
        }
        if constexpr (ALIGN_EPI) { if (wr == 0) PG8_BAR; }
        if constexpr (!Epi::AFTER_DRAIN) { E(acc, cur, wr, wc, fr, fq); S.done(cur); }
        if (!has_next) break;
#pragma unroll
        for (int a = 0; a < 2; ++a)
#pragma unroll
            for (int b = 0; b < 2; ++b)
#pragma unroll
                for (int m = 0; m < 4; ++m)
#pragma unroll
                    for (int n = 0; n < 2; ++n) acc[a][b][m][n] = (f32x4){0.f, 0.f, 0.f, 0.f};
        cur = nxt; cA = nA; cB = nB; ++ui;
        if constexpr (ALIGN_EPI) { if (wr == 1) PG8_BAR; }
    }
    PG8_WAIT_V(0);
    if constexpr (!ALIGN_EPI) { if (wr == 0) PG8_BAR; }
    PG8_BAR;
    if constexpr (Epi::AFTER_DRAIN) { E.fused(acc, cur, wr, wc, fr, fq, lds, wid, lane); S.done(cur); }
#undef PG8_SA
#undef PG8_SB
#undef PG8_STAGE
#undef PG8_LDA
#undef PG8_LDB
#undef PG8_MMA
#undef PG8_WAIT_V
#undef PG8_WAIT_L
#undef PG8_BAR
#undef PG8_SCHED
}
}

typedef unsigned short bf16;
typedef float f32x4 __attribute__((ext_vector_type(4)));
typedef unsigned u32x4 __attribute__((ext_vector_type(4)));
typedef unsigned u32x2 __attribute__((ext_vector_type(2)));
constexpr int L_SEQ = 8192, T_TOK = 16384, D = 1024, FF = 4096, NMEMT = 512;
constexpr int NFFT = 16384;
constexpr float RMS_EPS = 1e-6f;
constexpr int LDS_BYTES = 155648;
constexpr size_t MiB = 1u << 20;
constexpr size_t WS_NORMS = 0;
constexpr size_t WS_KT0B = 8192;
constexpr size_t WS_BAR = 16384, WS_BAR_BYTES = 16384;
constexpr size_t WS_TW = 65536;
constexpr size_t WS_S5F = 1 * MiB;
constexpr size_t WS_H2 = 4 * MiB;
constexpr size_t WS_MN = 6 * MiB;
constexpr size_t WS_KB = 7 * MiB;
constexpr size_t WS_VT = 8 * MiB;
constexpr size_t WS_PART = 9 * MiB;
constexpr size_t WS_W = 16 * MiB;
constexpr size_t W_IN = 0, W_OUT = 4 * MiB, W_Q = 6 * MiB, W_K = 8 * MiB, W_V = 10 * MiB, W_O = 12 * MiB, W_1 = 14 * MiB, W_2 = 22 * MiB, W_GLU = 30 * MiB;
constexpr size_t WS_HN = 48 * MiB;
constexpr size_t WS_MIXOUT = 80 * MiB;
constexpr size_t WS_MIXIN = 112 * MiB;
constexpr size_t WS_R = 144 * MiB;
constexpr size_t R_P = 0;
constexpr size_t R_Q = 0, R_SC = 32 * MiB, R_PROB = 96 * MiB;
constexpr size_t R_H = 0;
constexpr size_t R_SPEC = 0, R_KT = 64 * MiB, R_PT = 64 * MiB, R_Y = 64 * MiB, R_PS5 = 112 * MiB, R_G = 128 * MiB, R_YT = 144 * MiB;
constexpr size_t WS_END = WS_R + 160 * MiB;

struct Args { const float* in[37]; float* out; unsigned char* ws; };
constexpr int TAB_OFF = LDS_BYTES - 512;
__device__ __forceinline__ const void* ldptr(const unsigned char* lds, int i) {
    const volatile unsigned* p = (const volatile unsigned*)(lds + TAB_OFF) + 2 * i;
    const unsigned lo = __builtin_amdgcn_readfirstlane(p[0]), hi = __builtin_amdgcn_readfirstlane(p[1]);
    return (const void*)(((unsigned long long)hi << 32) | lo);
}

__device__ __forceinline__ float bf2f(bf16 v) { return __uint_as_float((unsigned)v << 16); }
__device__ __forceinline__ unsigned f2bf(float f) { unsigned u = __float_as_uint(f); return (u + 0x7fffu + ((u >> 16) & 1u)) >> 16; }
__device__ __forceinline__ unsigned pk2(float lo, float hi) { return f2bf(lo) | (f2bf(hi) << 16); }
__device__ __forceinline__ float wave_sum(float v) {
#pragma unroll
    for (int o = 1; o < 64; o <<= 1) v += __shfl_xor(v, o);
    return v;
}
__device__ __forceinline__ float wave_max(float v) {
#pragma unroll
    for (int o = 1; o < 64; o <<= 1) v = fmaxf(v, __shfl_xor(v, o));
    return v;
}
#define XB_TMO      128
#define XB_XCNT(j)  (256  + 64 * (j))
#define XB_XSUB(j)  (1280 + 64 * (j))
#define XB_XGEN(j)  (2304 + 64 * (j))
#define XB_TOP      3328
#define XB_TOPGEN   3392
#define XCD_BAR_WORDS 3456
#define XB_SPIN_CAP (1u << 18)

__device__ __forceinline__ unsigned xb_ld(unsigned* p)              { return __hip_atomic_load(p, __ATOMIC_RELAXED, __HIP_MEMORY_SCOPE_AGENT); }
__device__ __forceinline__ unsigned xb_add(unsigned* p, unsigned v) { return __hip_atomic_fetch_add(p, v, __ATOMIC_RELAXED, __HIP_MEMORY_SCOPE_AGENT); }
__device__ __forceinline__ unsigned xb_xcc_id() { return (unsigned)__builtin_amdgcn_s_getreg((3 << 11) | 20) & 0xFu; }
#define XB_SPIN(cond, bar) do { unsigned _sp = 0; while (cond) { __builtin_amdgcn_s_sleep(1); \
    if ((++_sp & 255u) == 0u) { if (xb_ld(&(bar)[XB_TMO])) break; if (_sp > XB_SPIN_CAP) { atomicAdd(&(bar)[XB_TMO], 1u); break; } } } } while (0)

struct XcdBarrier {
    unsigned* bar; unsigned x;
    volatile __attribute__((address_space(3))) unsigned* st;
};

__device__ __forceinline__ XcdBarrier xcd_barrier_post(unsigned* bar, volatile __attribute__((address_space(3))) unsigned* st) {
    XcdBarrier b; b.bar = bar; b.x = xb_xcc_id(); b.st = st;
    if (threadIdx.x == 0) (void)xb_add(&bar[XB_XCNT(b.x)], 1u);
    return b;
}
__device__ __forceinline__ void xcd_barrier_complete(unsigned* bar, unsigned x, unsigned& nloc, unsigned& nx) {
    const unsigned G = gridDim.x * gridDim.y * gridDim.z;
    unsigned sum, cnt, mine, sp = 0u;
    for (;;) {
        sum = 0u; cnt = 0u; mine = 0u;
#pragma unroll
        for (unsigned j = 0; j < 16; ++j) { const unsigned c = xb_ld(&bar[XB_XCNT(j)]); sum += c; cnt += (c > 0u) ? 1u : 0u; mine = (j == x) ? c : mine; }
        if (sum == G) break;
        __builtin_amdgcn_s_sleep(1);
        if ((++sp & 255u) == 0u) { if (xb_ld(&bar[XB_TMO])) break; if (sp > XB_SPIN_CAP) { atomicAdd(&bar[XB_TMO], 1u); break; } }
    }
    nloc = mine > 0u ? mine : 1u; nx = cnt > 0u ? cnt : 1u;
}

__device__ __forceinline__ void xcd_barrier(const XcdBarrier& b) {
    asm volatile("s_waitcnt vmcnt(0)" ::: "memory");
    __syncthreads();
    if (threadIdx.x == 0) {
        unsigned* bar = b.bar;
        __builtin_amdgcn_s_waitcnt(0);
        unsigned nloc = b.st[0], nx = b.st[1];
        if (nloc == 0u) { xcd_barrier_complete(bar, b.x, nloc, nx); b.st[0] = nloc; b.st[1] = nx; }
        const unsigned old = xb_add(&bar[XB_XSUB(b.x)], 1u);
        const unsigned gen = old / nloc;
        if (old + 1u == (gen + 1u) * nloc) {
            __builtin_amdgcn_fence(__ATOMIC_RELEASE, "agent");
            asm volatile("s_waitcnt vmcnt(0)" ::: "memory");
            const unsigned og = xb_add(&bar[XB_TOP], 1u);
            const unsigned tg = og / nx;
            if (og + 1u == (tg + 1u) * nx) xb_add(&bar[XB_TOPGEN], 1u);
            else XB_SPIN(xb_ld(&bar[XB_TOPGEN]) == tg, bar);
            __builtin_amdgcn_fence(__ATOMIC_ACQUIRE, "agent");
            xb_add(&bar[XB_XGEN(b.x)], 1u);
            asm volatile("s_waitcnt vmcnt(0)" ::: "memory");
        } else {
            XB_SPIN(xb_ld(&bar[XB_XGEN(b.x)]) == gen, bar);
            __builtin_amdgcn_fence(__ATOMIC_ACQUIRE, "agent");
            asm volatile("s_waitcnt vmcnt(0)" ::: "memory");
        }
    }
    __syncthreads();
}

#define LDS_FENCE() asm volatile("s_waitcnt lgkmcnt(0)" ::: "memory")

__device__ __forceinline__ void transpose_item(const float* W, int ldw, int ncols, bf16* WT, int ldt, float* scr, int item, int lane) {
    const int nblk = ncols / 32, kb = item / nblk, nb = item % nblk, k0 = 64 * kb, n0 = 32 * nb;
#pragma unroll 8
    for (int i = 0; i < 32; ++i) { const int kk = 2 * i + (lane >> 5); scr[kk * 33 + (lane & 31)] = W[(size_t)(k0 + kk) * ldw + n0 + (lane & 31)]; }
    LDS_FENCE();
    const int c = lane & 7;
#pragma unroll
    for (int j = 0; j < 4; ++j) { const int n = (lane >> 3) + 8 * j; const float* s = scr + (8 * c) * 33 + n;
        u32x4 o; o.x = pk2(s[0 * 33], s[1 * 33]); o.y = pk2(s[2 * 33], s[3 * 33]); o.z = pk2(s[4 * 33], s[5 * 33]); o.w = pk2(s[6 * 33], s[7 * 33]);
        *(u32x4*)(WT + (size_t)(n0 + n) * ldt + k0 + 8 * c) = o; }
    LDS_FENCE();
}

__device__ __forceinline__ void norm_row(const float* xin, float* xout, const bf16* br, const float* gpost, const float* gpre, bf16* hn, int lane) {
    f32x4 v[4];
#pragma unroll
    for (int j = 0; j < 4; ++j) v[j] = *((const f32x4*)xin + lane + 64 * j);
    if (br) {
        f32x4 r[4]; float ss = 0.f;
#pragma unroll
        for (int j = 0; j < 4; ++j) { const u32x2 w = *((const u32x2*)br + lane + 64 * j);
            r[j] = (f32x4){pg8::bfl(w.x), pg8::bfh(w.x), pg8::bfl(w.y), pg8::bfh(w.y)}; ss += (r[j].x * r[j].x + r[j].y * r[j].y) + (r[j].z * r[j].z + r[j].w * r[j].w); }
        const float rstd = rsqrtf(wave_sum(ss) * (1.f / D) + RMS_EPS);
#pragma unroll
        for (int j = 0; j < 4; ++j) { const f32x4 g = *((const f32x4*)gpost + lane + 64 * j); v[j] = v[j] + r[j] * rstd * g; }
    }
    if (xout) {
#pragma unroll
        for (int j = 0; j < 4; ++j) *((f32x4*)xout + lane + 64 * j) = v[j];
    }
    if (hn) {
        float ss = 0.f;
#pragma unroll
        for (int j = 0; j < 4; ++j) ss += (v[j].x * v[j].x + v[j].y * v[j].y) + (v[j].z * v[j].z + v[j].w * v[j].w);
        const float rstd = rsqrtf(wave_sum(ss) * (1.f / D) + RMS_EPS);
#pragma unroll
        for (int j = 0; j < 4; ++j) { const f32x4 g = *((const f32x4*)gpre + lane + 64 * j); const f32x4 o = v[j] * rstd * g;
            u32x2 w; w.x = pk2(o.x, o.y); w.y = pk2(o.z, o.w); *((u32x2*)hn + lane + 64 * j) = w; }
    }
}

#define PADI(i) ((i) + (((i) >> 6) << 2))
constexpr int FFT_LDS_ELEMS = 16384 + 1024;
constexpr int TWL_OFF = FFT_LDS_ELEMS * 8;
__device__ __forceinline__ float2 cmul(float2 a, float2 b) { return make_float2(a.x * b.x - a.y * b.y, a.x * b.y + a.y * b.x); }
__device__ __forceinline__ float2 cmulc(float2 a, float2 b) { return make_float2(a.x * b.x + a.y * b.y, a.y * b.x - a.x * b.y); }
template <bool INV> __device__ __forceinline__ void fft16(float2 (&r)[16]) {
    const float C[8] = {1.f, 0.9238795325112867f, 0.7071067811865476f, 0.3826834323650898f, 0.f, -0.3826834323650898f, -0.7071067811865476f, -0.9238795325112867f};
    const float S[8] = {0.f, 0.3826834323650898f, 0.7071067811865476f, 0.9238795325112867f, 1.f, 0.9238795325112867f, 0.7071067811865476f, 0.3826834323650898f};
#pragma unroll
    for (int st = 0; st < 4; ++st) {
        const int ls = INV ? st : 3 - st, s = 1 << ls;
#pragma unroll
        for (int b = 0; b < 8; ++b) {
            const int off = b & (s - 1), i = ((b >> ls) << (ls + 1)) + off, k = off << (3 - ls);
            const float2 a = r[i], c = r[i + s];
            if (!INV) {
                const float2 d = make_float2(a.x - c.x, a.y - c.y);
                r[i] = make_float2(a.x + c.x, a.y + c.y);
                if (k == 0) r[i + s] = d; else if (k == 4) r[i + s] = make_float2(d.y, -d.x); else r[i + s] = cmul(d, make_float2(C[k], -S[k]));
            } else {
                float2 bb; if (k == 0) bb = c; else if (k == 4) bb = make_float2(-c.y, c.x); else bb = cmulc(c, make_float2(C[k], -S[k]));
                r[i] = make_float2(a.x + bb.x, a.y + bb.y); r[i + s] = make_float2(a.x - bb.x, a.y - bb.y);
            }
        }
    }
}
template <bool INV, int LSM> __device__ __forceinline__ void fft_pass16(float2* x, const float2* twl, int tid) {
    constexpr int SH = 10 - LSM;
    constexpr int QS = (LSM >= 6) ? ((1 << LSM) + ((1 << LSM) >> 4)) : (1 << LSM);
#pragma unroll 1
    for (int w = tid; w < 1024; w += 512) {
        const int j = w & ((1 << LSM) - 1), base = (w >> LSM) << (LSM + 4);
        float2* px = x + PADI(base + j);
        float2 r[16];
#pragma unroll
        for (int q = 0; q < 16; ++q) r[q] = px[q * QS];
        const float2 th = twl[j << SH];
        float2 pw[16];
        pw[1] = th; pw[2] = cmul(th, th); pw[3] = cmul(pw[2], th); pw[4] = cmul(pw[2], pw[2]); pw[5] = cmul(pw[4], th); pw[6] = cmul(pw[3], pw[3]); pw[7] = cmul(pw[6], th);
        pw[8] = cmul(pw[4], pw[4]); pw[9] = cmul(pw[8], th); pw[10] = cmul(pw[5], pw[5]); pw[11] = cmul(pw[10], th); pw[12] = cmul(pw[6], pw[6]); pw[13] = cmul(pw[12], th); pw[14] = cmul(pw[7], pw[7]); pw[15] = cmul(pw[14], th);
        if (!INV) fft16<false>(r);
#pragma unroll
        for (int p = 1; p < 16; ++p) { const int br = ((p & 1) << 3) | ((p & 2) << 1) | ((p & 4) >> 1) | ((p & 8) >> 3); r[p] = INV ? cmulc(r[p], pw[br]) : cmul(r[p], pw[br]); }
        if (INV) fft16<true>(r);
#pragma unroll
        for (int q = 0; q < 16; ++q) px[q * QS] = r[q];
    }
    __syncthreads();
}
template <bool INV> __device__ __forceinline__ void fft_pass4(float2* x, int tid) {
#pragma unroll 2
    for (int w = tid; w < 4096; w += 512) {
        float4* p = (float4*)(x + PADI(4 * w));
        const float4 v01 = p[0], v23 = p[1];
        const float2 r0 = make_float2(v01.x, v01.y), r1 = make_float2(v01.z, v01.w), r2 = make_float2(v23.x, v23.y), r3 = make_float2(v23.z, v23.w);
        if (!INV) {
            const float2 a0 = make_float2(r0.x + r2.x, r0.y + r2.y), a2 = make_float2(r0.x - r2.x, r0.y - r2.y), a1 = make_float2(r1.x + r3.x, r1.y + r3.y), d = make_float2(r1.x - r3.x, r1.y - r3.y);
            const float2 a3 = make_float2(d.y, -d.x);
            p[0] = make_float4(a0.x + a1.x, a0.y + a1.y, a0.x - a1.x, a0.y - a1.y); p[1] = make_float4(a2.x + a3.x, a2.y + a3.y, a2.x - a3.x, a2.y - a3.y);
        } else {
            const float2 a0 = make_float2(r0.x + r1.x, r0.y + r1.y), a1 = make_float2(r0.x - r1.x, r0.y - r1.y), a2 = make_float2(r2.x + r3.x, r2.y + r3.y), a3 = make_float2(r2.x - r3.x, r2.y - r3.y);
            const float2 b = make_float2(-a3.y, a3.x);
            p[0] = make_float4(a0.x + a2.x, a0.y + a2.y, a1.x + b.x, a1.y + b.y); p[1] = make_float4(a0.x - a2.x, a0.y - a2.y, a1.x - b.x, a1.y - b.y);
        }
    }
    __syncthreads();
}
__device__ __forceinline__ void fft_fwd(float2* x, const float2* twl, int tid) { fft_pass16<false, 10>(x, twl, tid); fft_pass16<false, 6>(x, twl, tid); fft_pass16<false, 2>(x, twl, tid); fft_pass4<false>(x, tid); }
__device__ __forceinline__ void fft_inv(float2* x, const float2* twl, int tid) { fft_pass4<true>(x, tid); fft_pass16<true, 2>(x, twl, tid); fft_pass16<true, 6>(x, twl, tid); fft_pass16<true, 10>(x, twl, tid); }
__device__ __forceinline__ void spec_mul(float2* x, const unsigned* __restrict__ sp, int tid) {
    for (int p = tid; p < NFFT; p += 512) { const unsigned w = sp[p]; const float kr = pg8::bfl(w), ki = pg8::bfh(w); const float2 a = x[PADI(p)]; x[PADI(p)] = make_float2(a.x * kr - a.y * ki, a.x * ki + a.y * kr); }
    __syncthreads();
}
__device__ __forceinline__ float hy_sc(const bf16* r, int t, float w0, float w1, float w2, float sb) {
    const float a = bf2f(r[max(t - 1, 0)]), b = bf2f(r[t]), c = bf2f(r[min(t + 1, L_SEQ - 1)]);
    return sb + w1 * b + (t > 0 ? w0 * a : 0.f) + (t < L_SEQ - 1 ? w2 * c : 0.f);
}
__device__ __forceinline__ float gelu_tanh(float x) { const float u = 0.7978845608028654f * (x + 0.044715f * x * x * x); return 0.5f * x * (1.f + tanhf(u)); }


typedef short bf16x8_t __attribute__((ext_vector_type(8)));
template <bool PASSB>
__device__ __forceinline__ void s5_pass(unsigned char* lds, int tid, int bid, int G, const bf16* PS5, float2* S5F, float* Y, bf16* Gb,
        const float* lam_re, const float* lam_im, const float* log_dt, const float* b_re, const float* b_im, const float* c_re, const float* c_im, const float* dskp) {
    const int lane = tid & 63, wave = __builtin_amdgcn_readfirstlane(tid >> 6), l15 = lane & 15, lq = lane >> 4, n = lane;
    float2* CL = (float2*)lds;
    float2* BUs = (float2*)(lds + 16384) + wave * (16 * 65);
    bf16* Sb = (bf16*)(lds + 16384 + 8 * 16 * 65 * 8) + wave * (16 * 136);
    for (int bt = bid; bt < 256; bt += G) {
        const int bgi = bt & 63, b = bgi >> 5, gq = bgi & 31, chunk = (bt >> 6) * 8 + wave;
        if (PASSB) {
            __syncthreads();
            for (int e = tid; e < 2048; e += 512) { const int d = e >> 10, nn = (e >> 4) & 63, h = e & 15;
                const size_t li = ((size_t)d * 32 + gq) * 64 + nn;
                const float lr = fminf(lam_re[li], -1e-4f), lim = lam_im[li], dtv = expf(log_dt[d * 32 + gq]);
                const float mag = expf(lr * dtv); float sn, cs; sincosf(lim * dtv, &sn, &cs); const float ar = mag * cs - 1.f, ai = mag * sn;
                const float den = 1.f / (lr * lr + lim * lim); const float cr = (ar * lr + ai * lim) * den, ci = (ai * lr - ar * lim) * den;
                const size_t cidx = (((size_t)d * 32 + gq) * 16 + h) * 64 + nn; const float xr = c_re[cidx], xi = c_im[cidx];
                CL[e] = make_float2(xr * cr - xi * ci, xr * ci + xi * cr); }
            __syncthreads();
        }
        bf16x8_t Bf[8];
#pragma unroll
        for (int f = 0; f < 8; ++f) { const float* src = ((f < 4) ? b_re : b_im) + ((size_t)gq * 64 + 16 * (f & 3) + l15) * 16 + 8 * (lq & 1);
            const f32x4 v0 = *(const f32x4*)src, v1 = *(const f32x4*)(src + 4);
            u32x4 w; w.x = pk2(v0.x, v0.y); w.y = pk2(v0.z, v0.w); w.z = pk2(v1.x, v1.y); w.w = pk2(v1.z, v1.w);
            if (lq >= 2) w = (u32x4){0u, 0u, 0u, 0u};
            Bf[f] = __builtin_bit_cast(bf16x8_t, w); }
        const float dsk = PASSB ? dskp[gq * 16 + l15] : 0.f;
        const size_t rowc = (size_t)b * L_SEQ + chunk * 256;
        for (int d = 0; d < 2; ++d) {
            const size_t li = ((size_t)d * 32 + gq) * 64 + n;
            const float lr = fminf(lam_re[li], -1e-4f), lim = lam_im[li], dtv = expf(log_dt[d * 32 + gq]);
            const float mag = expf(lr * dtv); float sn, cs; sincosf(lim * dtv, &sn, &cs); const float ar = mag * cs, ai = mag * sn;
            float sr = 0.f, si = 0.f;
            bf16x8_t Cf[4];
            if (PASSB) {
                float pr_ = ar, pi_ = ai;
#pragma unroll
                for (int q = 0; q < 8; ++q) { const float t0 = pr_ * pr_ - pi_ * pi_, t1 = 2.f * pr_ * pi_; pr_ = t0; pi_ = t1; }
                const float2* Fb = S5F + ((((size_t)d * 2 + b) * 32 + gq) * 32) * 64 + n;
                if (d == 0) { for (int cc = 0; cc < chunk; ++cc) { const float2 f = Fb[(size_t)cc * 64]; const float nr = pr_ * sr - pi_ * si + f.x, ni = pr_ * si + pi_ * sr + f.y; sr = nr; si = ni; } }
                else { for (int cc = 31; cc > chunk; --cc) { const float2 f = Fb[(size_t)cc * 64]; const float nr = pr_ * sr - pi_ * si + f.x, ni = pr_ * si + pi_ * sr + f.y; sr = nr; si = ni; } }
#pragma unroll
                for (int kk = 0; kk < 4; ++kk) { float cv[8];
#pragma unroll
                    for (int j = 0; j < 8; ++j) { const int nn = (32 * kk + 8 * lq + j) & 63; const float2 c = CL[d * 1024 + nn * 16 + l15]; cv[j] = (kk < 2) ? c.x : -c.y; }
                    u32x4 w; w.x = pk2(cv[0], cv[1]); w.y = pk2(cv[2], cv[3]); w.z = pk2(cv[4], cv[5]); w.w = pk2(cv[6], cv[7]);
                    Cf[kk] = __builtin_bit_cast(bf16x8_t, w); }
            }
            const bf16* ua = PS5 + (rowc + l15) * 512 + gq * 16 + 8 * (lq & 1);
            u32x4 aN = *(const u32x4*)(ua + (size_t)(d ? 15 : 0) * 16 * 512);
#pragma unroll 1
            for (int s_ = 0; s_ < 16; ++s_) {
                const int sc = d ? 15 - s_ : s_;
                u32x4 aC = aN; if (lq >= 2) aC = (u32x4){0u, 0u, 0u, 0u};
                if (s_ < 15) aN = *(const u32x4*)(ua + (size_t)(d ? sc - 1 : sc + 1) * 16 * 512);
                const bf16x8_t af = __builtin_bit_cast(bf16x8_t, aC);
                f32x4 acc[8];
#pragma unroll
                for (int f = 0; f < 8; ++f) acc[f] = __builtin_amdgcn_mfma_f32_16x16x32_bf16(af, Bf[f], (f32x4){0.f, 0.f, 0.f, 0.f}, 0, 0, 0);
#pragma unroll
                for (int i = 0; i < 4; ++i)
#pragma unroll
                    for (int f = 0; f < 4; ++f) BUs[(4 * lq + i) * 65 + 16 * f + l15] = make_float2(acc[f][i], acc[f + 4][i]);
                LDS_FENCE();
#pragma unroll
                for (int ii = 0; ii < 16; ++ii) { const int i = d ? 15 - ii : ii; const float2 bu = BUs[i * 65 + n];
                    const float nr = ar * sr - ai * si + bu.x, ni = ar * si + ai * sr + bu.y; sr = nr; si = ni;
                    if (PASSB) { Sb[i * 136 + n] = (bf16)f2bf(sr); Sb[i * 136 + 64 + n] = (bf16)f2bf(si); } }
                if (PASSB) {
                    LDS_FENCE();
                    f32x4 y = (f32x4){0.f, 0.f, 0.f, 0.f};
#pragma unroll
                    for (int kk = 0; kk < 4; ++kk) { const bf16x8_t sf = *(const bf16x8_t*)(Sb + l15 * 136 + 32 * kk + 8 * lq); y = __builtin_amdgcn_mfma_f32_16x16x32_bf16(sf, Cf[kk], y, 0, 0, 0); }
#pragma unroll
                    for (int i = 0; i < 4; ++i) { const size_t row = rowc + 16 * sc + 4 * lq + i; float* yp = Y + row * 512 + gq * 16 + l15;
                        if (d == 0) *yp = y[i];
                        else { const float v = *yp + y[i] + dsk * bf2f(PS5[row * 512 + gq * 16 + l15]); Gb[row * 512 + gq * 16 + l15] = (bf16)f2bf(gelu_tanh(v)); } }
                }
                LDS_FENCE();
            }
            if (!PASSB) S5F[((((size_t)d * 2 + b) * 32 + gq) * 32 + chunk) * 64 + n] = make_float2(sr, si);
        }
    }
}

enum { OP_CONVERT = 0, OP_F2, OP_F3, OP_GEMM_K, OP_GEMM_V, OP_GEMM_IN, OP_MIX1, OP_MIX2, OP_GEMM_GLU, OP_GEMM_OUT, OP_NORM_MIX, OP_GEMM_Q, OP_GEMM_S, OP_SOFTMAX, OP_GEMM_PV,
       OP_GEMM_O, OP_NORM_XA, OP_GEMM_UP, OP_GEMM_DOWN, OP_NORM_MLP, OP_COUNT };

__global__ void __launch_bounds__(512, 2) fwd_kernel(Args args) {
    extern __shared__ __attribute__((aligned(16))) unsigned char lds[];
    cg::grid_group grid = cg::this_grid();
#define GRID_SYNC() do { xcd_barrier(xbar); } while (0)
    { const int tid = threadIdx.x;
    if (tid < 37) ((unsigned long long*)(lds + TAB_OFF))[tid] = (unsigned long long)args.in[tid];
    if (tid == 37) ((unsigned long long*)(lds + TAB_OFF))[37] = (unsigned long long)args.out;
    if (tid == 38) ((unsigned long long*)(lds + TAB_OFF))[38] = (unsigned long long)args.ws;
      if (tid == 40 || tid == 41) ((unsigned*)(lds + TAB_OFF + 384))[tid - 40] = 0u; }
    __syncthreads();
    XcdBarrier xbar = xcd_barrier_post((unsigned*)(args.ws + WS_BAR), (volatile __attribute__((address_space(3))) unsigned*)(lds + TAB_OFF + 384));
    asm volatile("s_waitcnt vmcnt(0) lgkmcnt(0)" ::: "memory"); __syncthreads(); grid.sync();
#define INP(i) ((const float*)ldptr(lds, (i)))
    for (int layer_ = 0; layer_ < 4; ++layer_) {
#ifndef REPEAT_MASK
#define REPEAT_MASK 0u
#endif
        for (int opi = 0; opi < OP_COUNT * 2; ++opi) {
            const int op = opi >> 1;
            if ((opi & 1) && !((REPEAT_MASK >> op) & 1u)) continue;
            int tid = threadIdx.x; asm volatile("" : "+v"(tid));
            int bid = blockIdx.x; asm volatile("" : "+s"(bid));
            int G = gridDim.x; asm volatile("" : "+s"(G));
            int layer = layer_; asm volatile("" : "+s"(layer));
            const int lane = tid & 63, wave = __builtin_amdgcn_readfirstlane(tid >> 6);
            const int gw = bid * 8 + wave, NGW = G * 8, gt = bid * 512 + tid, GT = G * 512;
            const int jj = layer >> 1; const bool odd = (layer & 1) != 0;
            unsigned char* ws = (unsigned char*)ldptr(lds, 38);
            float* X = (float*)ldptr(lds, 37);
            float* KT0B = (float*)(ws + WS_KT0B); float2* TW = (float2*)(ws + WS_TW);
            float2* S5F = (float2*)(ws + WS_S5F); float* H2 = (float*)(ws + WS_H2);
            bf16* MN = (bf16*)(ws + WS_MN); bf16* KB = (bf16*)(ws + WS_KB); bf16* VT = (bf16*)(ws + WS_VT);
            unsigned char* WB = ws + WS_W;
            bf16* HN = (bf16*)(ws + WS_HN); bf16* MIXOUT = (bf16*)(ws + WS_MIXOUT); bf16* MIXIN = (bf16*)(ws + WS_MIXIN);
            unsigned char* R = ws + WS_R;

            bool do_sync = true;
            pg8::Gemm g{0, 0, 0}; pg8::Sched S{}; pg8::EpiRT E{}; bool is_gemm = false;
            S.G = G; S.c = bid; S.sa_n = 0; S.sb_b = 0;
            auto setg = [&](const void* A, int lda, const void* Bt, int ldb, int M, int N, int K) {
                g.K = K; g.lda = lda; g.ldb = ldb; S.nM = M / 256; S.nN = N / 256; S.nwg = S.nM * S.nN; S.A = (const char*)A; S.Bt = (const char*)Bt;
                S.sa_m = (size_t)256 * lda * 2; S.sb_n = (size_t)256 * ldb * 2; is_gemm = true; };
            switch (op) {
            case OP_GEMM_K: setg(MN, D, WB + W_K, D, NMEMT, D, D); E.mode = pg8::EP_BF16; E.O = KB; E.ldc = D; do_sync = false; break;
            case OP_GEMM_V: setg(MN, D, WB + W_V, D, NMEMT, D, D); E.mode = pg8::EP_VT; E.O = VT; do_sync = false; break;
            case OP_GEMM_IN: setg(HN, D, WB + W_IN, D, T_TOK, 2048, D);
                if (!odd) { E.mode = pg8::EP_BF16; E.O = R + R_P; E.ldc = 2048; } else { E.mode = pg8::EP_ODDIN; E.O = R + R_PS5; E.O2 = R + R_PT; } break;
            case OP_GEMM_GLU: if (odd) { setg(R + R_G, 512, WB + W_GLU, 512, T_TOK, 512, 512); E.mode = pg8::EP_GLU; E.O = MIXIN; E.ldc = D; E.aux = R + R_G; } break;
            case OP_GEMM_OUT: setg(MIXIN, D, WB + W_OUT, D, T_TOK, D, D); E.mode = pg8::EP_BF16; E.O = MIXOUT; E.ldc = D; break;
            case OP_GEMM_Q: setg(HN, D, WB + W_Q, D, T_TOK, D, D); E.mode = pg8::EP_BF16; E.O = R + R_Q; E.ldc = D; break;
            case OP_GEMM_S: setg(R + R_Q, D, KB, D, T_TOK, D, 256); S.sa_n = 512; S.sb_n = 512; S.sb_b = (size_t)256 * D * 2;
                E.mode = pg8::EP_F32S; E.O = R + R_SC; E.ldc = D; E.scale = 0.0625f; break;
            case OP_GEMM_PV: setg(R + R_PROB, D, VT, 256, T_TOK, D, 256); S.sa_n = 512; S.sb_n = (size_t)256 * 256 * 2; S.sb_b = (size_t)1024 * 256 * 2;
                E.mode = pg8::EP_BF16; E.O = R + R_Q; E.ldc = D; break;
            case OP_GEMM_O: setg(R + R_Q, D, WB + W_O, D, T_TOK, D, D); E.mode = pg8::EP_BF16; E.O = MIXOUT; E.ldc = D; break;
            case OP_GEMM_UP: setg(HN, D, WB + W_1, D, T_TOK, FF, D); E.mode = pg8::EP_RELU2; E.O = R + R_H; E.ldc = FF; break;
            case OP_GEMM_DOWN: setg(R + R_H, FF, WB + W_2, FF, T_TOK, D, FF); E.mode = pg8::EP_BF16; E.O = MIXOUT; E.ldc = D; break;
            default: break;
            }
            if (is_gemm) {
                pg8::gemm_phase<pg8::EpiRT, pg8::Sched, true, true>((PG8_LAS unsigned char*)lds, g, S, E, tid);
                __syncthreads();
                if (do_sync) GRID_SYNC();
                continue;
            }
            if (op == OP_CONVERT) {
                float* scr = (float*)(lds + wave * 16384);
                const float* Win = odd ? INP(17) + (size_t)jj * D * 2048 : INP(12) + (size_t)jj * D * 2048;
                const float* Wout = odd ? INP(36) + (size_t)jj * D * D : INP(16) + (size_t)jj * D * D;
                const int inc0 = odd ? 0 : 512;
                const int I_IN = (D / 64) * ((2048 - inc0) / 32), I_SQ = (D / 64) * (D / 32), I_1 = (D / 64) * (FF / 32), I_2 = (FF / 64) * (D / 32), I_GLU = odd ? (512 / 64) * (512 / 32) : 0;
                const int NIT = I_IN + 5 * I_SQ + I_1 + I_2 + I_GLU;
                for (int it = gw; it < NIT; it += NGW) {
                    int r = it;
                    if (r < I_IN) { transpose_item(Win + inc0, 2048, 2048 - inc0, (bf16*)(WB + W_IN) + (size_t)inc0 * D, D, scr, r, lane); continue; } r -= I_IN;
                    if (r < I_SQ) { transpose_item(Wout, D, D, (bf16*)(WB + W_OUT), D, scr, r, lane); continue; } r -= I_SQ;
                    if (r < I_SQ) { transpose_item(INP(6) + (size_t)layer * D * D, D, D, (bf16*)(WB + W_Q), D, scr, r, lane); continue; } r -= I_SQ;
                    if (r < I_SQ) { transpose_item(INP(7) + (size_t)layer * D * D, D, D, (bf16*)(WB + W_K), D, scr, r, lane); continue; } r -= I_SQ;
                    if (r < I_SQ) { transpose_item(INP(8) + (size_t)layer * D * D, D, D, (bf16*)(WB + W_V), D, scr, r, lane); continue; } r -= I_SQ;
                    if (r < I_SQ) { transpose_item(INP(9) + (size_t)layer * D * D, D, D, (bf16*)(WB + W_O), D, scr, r, lane); continue; } r -= I_SQ;
                    if (r < I_1) { transpose_item(INP(10) + (size_t)layer * D * FF, FF, FF, (bf16*)(WB + W_1), D, scr, r, lane); continue; } r -= I_1;
                    if (r < I_2) { transpose_item(INP(11) + (size_t)layer * FF * D, D, D, (bf16*)(WB + W_2), FF, scr, r, lane); continue; } r -= I_2;
                    transpose_item(INP(26) + (size_t)jj * 512 * 512, 512, 512, (bf16*)(WB + W_GLU), 512, scr, r, lane);
                }
                if (!odd) {
                    const float* Wg = INP(13) + (size_t)jj * 4 * 128 * 128; const float* psc = INP(14) + (size_t)jj * 512;
                    for (int o = gt; o < D * 512; o += GT) { const int k = o >> 9, n = o & 511, gq = n >> 7, d = n & 127;
                        const float* wr_ = Win + (size_t)k * 2048 + gq * 128; const float* wg = Wg + (size_t)gq * 128 * 128 + d; float acc = 0.f;
#pragma unroll 8
                        for (int c = 0; c < 128; ++c) acc += wr_[c] * wg[c * 128];
                        ((bf16*)(WB + W_IN))[(size_t)n * D + k] = (bf16)f2bf(acc * psc[n]); }
                }
                for (int m = gw; m < NMEMT; m += NGW) norm_row(INP(1) + (size_t)m * D, nullptr, nullptr, nullptr, INP(4) + (size_t)layer * D, MN + (size_t)m * D, lane);
                if (layer == 0) {
                    for (int m = gw; m < T_TOK; m += NGW) norm_row(INP(0) + (size_t)m * D, X + (size_t)m * D, nullptr, nullptr, INP(2), HN + (size_t)m * D, lane);
                    for (int k = gt; k < 8192; k += GT) { float sn, cs; sincospif((float)k * (2.0f / 16384.0f), &sn, &cs); TW[k] = make_float2(cs, -sn); }
                }
                if (odd) {
                    __syncthreads();
                    float* zs = (float*)lds; float* h1s = zs + 8 * 36;
                    const float* w1 = INP(29) + (size_t)jj * 33 * 64; const float* b1 = INP(30) + jj * 64; const float* w2 = INP(31) + (size_t)jj * 64 * 64; const float* b2 = INP(32) + jj * 64; const float* fr = INP(34) + jj * 64;
                    for (int tb = bid; tb < L_SEQ / 8; tb += G) {
                        __syncthreads();
                        if (tid < 8 * 33) { const int tl = tid / 33, k = tid % 33, t = tb * 8 + tl; float z;
                            if (k == 0) z = (float)t / (float)(L_SEQ - 1);
                            else { const int bnd = (k - 1) & 15; const float band = 1e-4f + (float)bnd * ((15.0f - 1e-4f) / 15.0f); const float ang = ((float)(2.0 * 3.14159265358979323846 / L_SEQ) * (float)t) * band;
                                z = (k <= 16) ? cosf(ang) : -sinf(ang); }
                            zs[tl * 36 + k] = z; }
                        __syncthreads();
                        const int tl = tid >> 6, j = tid & 63;
                        { float a = b1[j];
                            for (int k = 0; k < 33; ++k) a += zs[tl * 36 + k] * w1[k * 64 + j];
                            h1s[tl * 64 + j] = sinf(fr[j] * a); }
                        __syncthreads();
                        { float a = b2[j];
                            for (int k = 0; k < 64; ++k) a += h1s[tl * 64 + k] * w2[k * 64 + j];
                            H2[(size_t)(tb * 8 + tl) * 64 + j] = sinf(fr[j] * a); }
                    }
                }
            } else if (op == OP_F2) {
                if (!odd) continue;
                float* hs = (float*)lds; float* KT = (float*)(R + R_KT); float* PART = (float*)(ws + WS_PART);
                const float* w3 = INP(33) + (size_t)jj * 64 * 2048;
                for (int it = bid; it < 512; it += G) {
                    const int tt = it >> 2, cq = it & 3;
                    __syncthreads();
                    for (int e = tid; e < 64 * 64; e += 512) hs[(e >> 6) * 65 + (e & 63)] = H2[(size_t)tt * 4096 + e];
                    __syncthreads();
                    const int t = tt * 64 + lane; const float tn = (float)t / (float)(L_SEQ - 1);
                    for (int i = 0; i < 16; ++i) {
                        const int col = cq * 512 + wave * 64 + 4 * i;
                        float a0 = 0.f, a1 = 0.f, a2 = 0.f, a3 = 0.f;
#pragma unroll 8
                        for (int k = 0; k < 64; ++k) { const float h = hs[lane * 65 + k]; const f32x4 w = *(const f32x4*)(w3 + (size_t)k * 2048 + col); a0 += h * w.x; a1 += h * w.y; a2 += h * w.z; a3 += h * w.w; }
                        const int o = col >> 10, dir = (col >> 9) & 1, c0 = col & 511;
                        float av[4] = {a0, a1, a2, a3};
#pragma unroll
                        for (int e = 0; e < 4; ++e) { const int c = c0 + e;
                            const float lo_ = -4.605170185988091f / 1.5f, hi_ = -4.605170185988091f / 0.3f;
                            const float delta = fabsf(lo_ + (float)c * ((hi_ - lo_) / 511.0f));
                            const float v = av[e] * expf(-tn * delta);
                            const float sa = wave_sum(fabsf(v));
                            if (lane == 0) PART[(size_t)tt * 2048 + col + e] = sa;
                            float* kr = KT + (size_t)(o * 512 + c) * NFFT;
                            if (dir == 0) kr[t] = v; else if (t > 0) kr[NFFT - t] = v; else KT0B[o * 512 + c] = v; }
                    }
                }
            } else if (op == OP_F3) {
                if (!odd) continue;
                float2* x = (float2*)lds; const float* KT = (const float*)(R + R_KT); unsigned* SPEC = (unsigned*)(R + R_SPEC);
                float2* twl = (float2*)(lds + TWL_OFF);
                for (int k = tid; k < 1024; k += 512) twl[k] = TW[k];
                for (int f = bid; f < 1024; f += G) {
                    __syncthreads();
                    const float* kr = KT + (size_t)f * NFFT;
                    for (int p = tid; p < NFFT; p += 512) { float v = (p == L_SEQ) ? 0.f : kr[p]; if (p == 0) v += KT0B[f]; x[PADI(p)] = make_float2(v, 0.f); }
                    __syncthreads();
                    fft_fwd(x, twl, tid);
                    float nsum; { const float* PART = (const float*)(ws + WS_PART) + (size_t)(f >> 9) * 1024 + (f & 511);
                        nsum = (PART[(size_t)lane * 2048] + PART[(size_t)lane * 2048 + 512]) + (PART[(size_t)(lane + 64) * 2048] + PART[(size_t)(lane + 64) * 2048 + 512]); nsum = wave_sum(nsum); }
                    const float inv = 1.0f / ((nsum + 1e-6f) * (float)NFFT);
                    for (int p = tid; p < NFFT; p += 512) { const float2 a = x[PADI(p)]; SPEC[(size_t)f * NFFT + p] = pk2(a.x * inv, a.y * inv); }
                }
            } else if (op == OP_MIX1) {
                if (!odd) {
                    const bf16* P = (const bf16*)(R + R_P); const float* cw = INP(15) + (size_t)jj * 3 * 512;
                    for (int item = gt; item < T_TOK * 128; item += GT) {
                        const int row = item >> 7, c8 = item & 127, t = row & (L_SEQ - 1);
                        float o[8];
                        if (c8 < 64) {
                            const int c = c8 * 8, h = 1 << (c >> 7); const int lo = max(t - h, 0), hi = min(t + h, L_SEQ);
                            float s[8] = {0.f, 0.f, 0.f, 0.f, 0.f, 0.f, 0.f, 0.f};
                            const bf16* base = P + (size_t)(row - t) * 2048 + c;
                            for (int tau = lo; tau < hi; ++tau) { const u32x4 w = *(const u32x4*)(base + (size_t)tau * 2048);
                                s[0] += pg8::bfl(w.x); s[1] += pg8::bfh(w.x); s[2] += pg8::bfl(w.y); s[3] += pg8::bfh(w.y); s[4] += pg8::bfl(w.z); s[5] += pg8::bfh(w.z); s[6] += pg8::bfl(w.w); s[7] += pg8::bfh(w.w); }
                            const u32x4 w = *(const u32x4*)(base + (size_t)t * 2048); const float ic = 1.0f / (float)(hi - lo);
                            o[0] = s[0] * ic - pg8::bfl(w.x); o[1] = s[1] * ic - pg8::bfh(w.x); o[2] = s[2] * ic - pg8::bfl(w.y); o[3] = s[3] * ic - pg8::bfh(w.y);
                            o[4] = s[4] * ic - pg8::bfl(w.z); o[5] = s[5] * ic - pg8::bfh(w.z); o[6] = s[6] * ic - pg8::bfl(w.w); o[7] = s[7] * ic - pg8::bfh(w.w);
                        } else {
                            const int c = (c8 - 64) * 8; const bf16* pr = P + (size_t)row * 2048 + c;
                            float acc[8] = {0.f, 0.f, 0.f, 0.f, 0.f, 0.f, 0.f, 0.f};
#pragma unroll
                            for (int dt = -1; dt <= 1; ++dt) {
                                if (t + dt < 0 || t + dt >= L_SEQ) continue;
                                const u32x4 cg_ = *(const u32x4*)(pr + (ptrdiff_t)dt * 2048 + 1024), hv = *(const u32x4*)(pr + (ptrdiff_t)dt * 2048 + 1536);
                                const f32x4 wa = *(const f32x4*)(cw + (dt + 1) * 512 + c), wb = *(const f32x4*)(cw + (dt + 1) * 512 + c + 4);
                                acc[0] += wa.x * pg8::bfl(cg_.x) * pg8::bfl(hv.x); acc[1] += wa.y * pg8::bfh(cg_.x) * pg8::bfh(hv.x); acc[2] += wa.z * pg8::bfl(cg_.y) * pg8::bfl(hv.y); acc[3] += wa.w * pg8::bfh(cg_.y) * pg8::bfh(hv.y);
                                acc[4] += wb.x * pg8::bfl(cg_.z) * pg8::bfl(hv.z); acc[5] += wb.y * pg8::bfh(cg_.z) * pg8::bfh(hv.z); acc[6] += wb.z * pg8::bfl(cg_.w) * pg8::bfl(hv.w); acc[7] += wb.w * pg8::bfh(cg_.w) * pg8::bfh(hv.w);
                            }
                            const u32x4 bg = *(const u32x4*)(pr + 512);
                            o[0] = acc[0] * pg8::bfl(bg.x); o[1] = acc[1] * pg8::bfh(bg.x); o[2] = acc[2] * pg8::bfl(bg.y); o[3] = acc[3] * pg8::bfh(bg.y);
                            o[4] = acc[4] * pg8::bfl(bg.z); o[5] = acc[5] * pg8::bfh(bg.z); o[6] = acc[6] * pg8::bfl(bg.w); o[7] = acc[7] * pg8::bfh(bg.w);
                        }
                        u32x4 w; w.x = pk2(o[0], o[1]); w.y = pk2(o[2], o[3]); w.z = pk2(o[4], o[5]); w.w = pk2(o[6], o[7]);
                        *(u32x4*)(MIXIN + (size_t)row * D + c8 * 8) = w;
                    }
                } else {
                    s5_pass<false>(lds, tid, bid, G, (const bf16*)(R + R_PS5), S5F, nullptr, nullptr, INP(18) + (size_t)jj * 2 * 32 * 64, INP(19) + (size_t)jj * 2 * 32 * 64, INP(20) + (size_t)jj * 2 * 32,
                                   INP(21) + (size_t)jj * 32 * 64 * 16, INP(22) + (size_t)jj * 32 * 64 * 16, nullptr, nullptr, nullptr);
                    __syncthreads();
                    float2* x = (float2*)lds; const bf16* PT = (const bf16*)(R + R_PT); const unsigned* SPEC = (const unsigned*)(R + R_SPEC); bf16* YT = (bf16*)(R + R_YT);
                    const float* sw = INP(27) + (size_t)jj * 3 * 1536; const float* sbv = INP(28) + (size_t)jj * 1536; const float* hb = INP(35) + (size_t)jj * 2 * 512;
                    float2* twl = (float2*)(lds + TWL_OFF);
                    for (int k = tid; k < 1024; k += 512) twl[k] = TW[k];
                    for (int c = bid; c < 512; c += G) {
                        int tid_h = threadIdx.x; asm volatile("" : "+v"(tid_h));
                        const bf16* r_go = PT + (size_t)c * T_TOK; const bf16* r_gm = PT + (size_t)(512 + c) * T_TOK; const bf16* r_v = PT + (size_t)(1024 + c) * T_TOK;
                        const float go0 = sw[c], go1 = sw[1536 + c], go2 = sw[3072 + c], gob = sbv[c];
                        const float gm0 = sw[512 + c], gm1 = sw[1536 + 512 + c], gm2 = sw[3072 + 512 + c], gmb = sbv[512 + c];
                        const float v0 = sw[1024 + c], v1 = sw[1536 + 1024 + c], v2 = sw[3072 + 1024 + c], vb = sbv[1024 + c];
                        const float bias0 = hb[c], bias1 = hb[512 + c];
                        __syncthreads();
                        for (int t = tid_h; t < L_SEQ; t += 512) { x[PADI(t)] = make_float2(hy_sc(r_v, t, v0, v1, v2, vb), hy_sc(r_v + L_SEQ, t, v0, v1, v2, vb)); x[PADI(L_SEQ) + PADI(t)] = make_float2(0.f, 0.f); }
                        __syncthreads();
                        fft_fwd(x, twl, tid); spec_mul(x, SPEC + (size_t)c * NFFT, tid); fft_inv(x, twl, tid);
                        float2 zr[16];
#pragma unroll
                        for (int i = 0; i < 16; ++i) { const int t = tid_h + 512 * i; const float2 y1 = x[PADI(t)];
                            const float va = hy_sc(r_v, t, v0, v1, v2, vb), vbb = hy_sc(r_v + L_SEQ, t, v0, v1, v2, vb);
                            const float ga = hy_sc(r_gm, t, gm0, gm1, gm2, gmb), gb = hy_sc(r_gm + L_SEQ, t, gm0, gm1, gm2, gmb);
                            zr[i] = make_float2(ga * (y1.x + va * bias0), gb * (y1.y + vbb * bias0));
                            x[PADI(t)] = zr[i]; x[PADI(L_SEQ) + PADI(t)] = make_float2(0.f, 0.f); }
                        __syncthreads();
                        fft_fwd(x, twl, tid); spec_mul(x, SPEC + (size_t)(512 + c) * NFFT, tid); fft_inv(x, twl, tid);
#pragma unroll
                        for (int i = 0; i < 16; ++i) { const int t = tid_h + 512 * i; const float2 y2 = x[PADI(t)];
                            const float ga = hy_sc(r_go, t, go0, go1, go2, gob), gb = hy_sc(r_go + L_SEQ, t, go0, go1, go2, gob);
                            YT[(size_t)c * T_TOK + t] = (bf16)f2bf(ga * (y2.x + zr[i].x * bias1));
                            YT[(size_t)c * T_TOK + L_SEQ + t] = (bf16)f2bf(gb * (y2.y + zr[i].y * bias1)); }
                    }
                }
            } else if (op == OP_MIX2) {
                if (!odd) continue;
                s5_pass<true>(lds, tid, bid, G, (const bf16*)(R + R_PS5), S5F, (float*)(R + R_Y), (bf16*)(R + R_G), INP(18) + (size_t)jj * 2 * 32 * 64, INP(19) + (size_t)jj * 2 * 32 * 64, INP(20) + (size_t)jj * 2 * 32,
                              INP(21) + (size_t)jj * 32 * 64 * 16, INP(22) + (size_t)jj * 32 * 64 * 16, INP(23) + (size_t)jj * 2 * 32 * 16 * 64, INP(24) + (size_t)jj * 2 * 32 * 16 * 64, INP(25) + (size_t)jj * 512);
                __syncthreads();
                { bf16* ts = (bf16*)lds + wave * (64 * 66); const bf16* YT = (const bf16*)(R + R_YT);
                  for (int it = gw; it < 8 * 256; it += NGW) { const int cb = it & 7, tb = it >> 3;
                      for (int cl = 0; cl < 64; ++cl) ts[cl * 66 + lane] = YT[(size_t)(cb * 64 + cl) * T_TOK + tb * 64 + lane];
                      LDS_FENCE();
                      for (int tl = 0; tl < 64; ++tl) MIXIN[(size_t)(tb * 64 + tl) * D + 512 + cb * 64 + lane] = ts[lane * 66 + tl];
                      LDS_FENCE(); } }
            } else if (op == OP_SOFTMAX) {
                const float* SC = (const float*)(R + R_SC); bf16* PR = (bf16*)(R + R_PROB);
                for (int it = gw; it < T_TOK * 4; it += NGW) {
                    const f32x4 s = *((const f32x4*)(SC + (size_t)it * 256) + lane);
                    const float m = wave_max(fmaxf(fmaxf(s.x, s.y), fmaxf(s.z, s.w)));
                    const float e0 = __expf(s.x - m), e1 = __expf(s.y - m), e2 = __expf(s.z - m), e3 = __expf(s.w - m);
                    const float inv = 1.f / wave_sum((e0 + e1) + (e2 + e3));
                    u32x2 w; w.x = pk2(e0 * inv, e1 * inv); w.y = pk2(e2 * inv, e3 * inv);
                    *((u32x2*)(PR + (size_t)it * 256) + lane) = w;
                }
            } else if (op == OP_NORM_MIX || op == OP_NORM_XA || op == OP_NORM_MLP) {
                const float* gpost = (op == OP_NORM_MIX) ? INP(2) + (size_t)(layer * 2 + 1) * D : (op == OP_NORM_XA) ? INP(3) + (size_t)(layer * 2 + 1) * D : INP(5) + (size_t)(layer * 2 + 1) * D;
                const float* gpre = (op == OP_NORM_MIX) ? INP(3) + (size_t)(layer * 2) * D : (op == OP_NORM_XA) ? INP(5) + (size_t)(layer * 2) * D : INP(2) + (size_t)((layer + 1) * 2) * D;
                const bool want_hn = !(op == OP_NORM_MLP && layer == 3);
                for (int m = gw; m < T_TOK; m += NGW) norm_row(X + (size_t)m * D, X + (size_t)m * D, MIXOUT + (size_t)m * D, gpost, gpre, want_hn ? HN + (size_t)m * D : nullptr, lane);
            } else { continue; }
            GRID_SYNC();
        }
    }
}

extern "C" void kernel_launch(void* const* d_in, const int* in_sizes, int n_in, void* d_out, int out_size, void* d_ws, size_t ws_size, hipStream_t stream) {
    static int grid = 0;
    if (grid == 0) {
        if (n_in != 37 || out_size != T_TOK * D || ws_size < WS_END) { fprintf(stderr, "kernel_launch: unexpected shapes (n_in %d out %d ws %zu, need ws >= %zu)\n", n_in, out_size, ws_size, (size_t)WS_END); grid = -1; return; }
        int dev = 0, cus = 0, per_cu = 0;
        (void)hipGetDevice(&dev);
        (void)hipDeviceGetAttribute(&cus, hipDeviceAttributeMultiprocessorCount, dev);
        (void)hipFuncSetAttribute((const void*)fwd_kernel, hipFuncAttributeMaxDynamicSharedMemorySize, LDS_BYTES);
        (void)hipOccupancyMaxActiveBlocksPerMultiprocessor(&per_cu, (const void*)fwd_kernel, 512, LDS_BYTES);
        (void)hipGetLastError();
        grid = cus > 0 ? cus : 256;
        fprintf(stderr, "kernel_launch: grid %d (per_cu %d) ws %zu\n", grid, per_cu, ws_size);
    }
    if (grid < 0) return;
    if (hipMemsetAsync((char*)d_ws + WS_BAR, 0, WS_BAR_BYTES, stream) != hipSuccess) { fprintf(stderr, "kernel_launch: memset failed\n"); return; }
    Args a{};
    for (int i = 0; i < 37; ++i) a.in[i] = (const float*)d_in[i];
    a.out = (float*)d_out; a.ws = (unsigned char*)d_ws;
    void* kargs[] = {&a};
    hipError_t e = hipLaunchCooperativeKernel((void*)fwd_kernel, dim3(grid), dim3(512), kargs, LDS_BYTES, stream);
    if (e != hipSuccess) fprintf(stderr, "kernel_launch: cooperative launch failed: %s\n", hipGetErrorString(e));
}
```

```cpp
#include <hip/hip_runtime.h>
#include <hip/hip_cooperative_groups.h>
#include <cstdio>
#include <cstdint>
namespace cg = cooperative_groups;

namespace pg8 {
#define PG8_LAS __attribute__((address_space(3)))
typedef unsigned short bf16_t;
typedef short bf16x8 __attribute__((ext_vector_type(8)));
typedef float f32x4 __attribute__((ext_vector_type(4)));
typedef unsigned u32x4 __attribute__((ext_vector_type(4)));
constexpr int BM = 256, BK = 64, HALF = 128, HTB = HALF * BK * 2  , STAGE_BYTES = 8 * HTB, NXCD = 8, WGM = 8;

__host__ __device__ __forceinline__ int lds_byte(int r, int c) { const int st = (r >> 4) * 2 + (c >> 5), rr = r & 15, cc = c & 31, ob = rr * 64 + cc * 2; return st * 1024 + (ob ^ (((ob >> 9) & 1) << 5)); }
__host__ __device__ __forceinline__ void stage_rc(int b, int& R, int& C) { const int st = b / 1024, sb = b % 1024, swz = sb ^ (((sb >> 9) & 1) << 5); R = (st >> 1) * 16 + swz / 64; C = (st & 1) * 32 + (swz % 64) / 2; }
__host__ __device__ __forceinline__ int perm32(int rho) { const int n = rho >> 4, i = rho & 15; return 8 * (i >> 2) + 4 * n + (i & 3); }

struct Unit { int pm, pn; const char* a; const char* b; };
struct Gemm { int K, lda, ldb; };

struct Sched {
    int nM, nN, nwg, G, c; const char* A; const char* Bt; size_t sa_m, sa_n, sb_n, sb_b;
    __device__ __forceinline__ bool next(int i, Unit& u) const {
        const long L = (long)i * G + c; if (L >= nwg) return false;
        int wgid = (int)L; { const int q = nwg / NXCD, r = nwg % NXCD, xcd = wgid % NXCD, off = wgid / NXCD; wgid = (xcd < r ? xcd * (q + 1) : r * (q + 1) + (xcd - r) * q) + off; }
        const int nig = WGM * nN, gid = wgid / nig, fm = gid * WGM, gsz = (nM - fm) < WGM ? (nM - fm) : WGM;
        u.pm = fm + ((wgid % nig) % gsz); u.pn = (wgid % nig) / gsz;
        u.a = A + (size_t)u.pm * sa_m + (size_t)u.pn * sa_n; u.b = Bt + (size_t)u.pn * sb_n + (size_t)(u.pm >> 5) * sb_b; return true;
    }
    __device__ __forceinline__ void a_ready(const Unit&) const {}
    __device__ __forceinline__ void done(const Unit&) const {}
};

__device__ __forceinline__ unsigned cvt_pk_bf16(float lo, float hi) { unsigned r; asm volatile("v_cvt_pk_bf16_f32 %0, %1, %2" : "=v"(r) : "v"(lo), "v"(hi)); return r; }
__device__ __forceinline__ float bfl(unsigned w) { return __uint_as_float(w << 16); }
__device__ __forceinline__ float bfh(unsigned w) { return __uint_as_float(w & 0xffff0000u); }

enum { EP_BF16 = 0, EP_RELU2 = 1, EP_F32S = 2, EP_ODDIN = 3, EP_VT = 4, EP_GLU = 5, EP_F2 = 6 };
struct EpiRT {
    static constexpr bool PERM = true, AFTER_DRAIN = false;
    int mode; void* O; void* O2; const void* aux; int ldc; float scale;
    __device__ __forceinline__ void operator()(const f32x4 (&acc)[2][2][4][2], const Unit& u, int wr, int wc, int fr, int fq) const {
        if (mode == EP_F2) {
            float* KT = (float*)O; float* KT0B = (float*)O2; float* PART = (float*)const_cast<void*>(aux);
#pragma unroll
            for (int bj = 0; bj < 2; ++bj) {
                const int col0 = u.pn * BM + bj * HALF + wc * 32 + 8 * fq, o = col0 >> 10, dir = (col0 >> 9) & 1, c0 = col0 & 511;
                float cs[8], dl[8];
#pragma unroll
                for (int e = 0; e < 8; ++e) { cs[e] = 0.f; const float lo_ = -4.605170185988091f / 1.5f, hi_ = -4.605170185988091f / 0.3f; dl[e] = fabsf(lo_ + (float)(c0 + e) * ((hi_ - lo_) / 511.0f)); }
#pragma unroll
                for (int ai = 0; ai < 2; ++ai)
#pragma unroll
                    for (int m = 0; m < 4; ++m) {
                        const int t = u.pm * BM + ai * HALF + wr * 64 + m * 16 + fr; const float tn = (float)t / 8191.0f;
#pragma unroll
                        for (int e = 0; e < 8; ++e) {
                            const float v = acc[ai][bj][m][e >> 2][e & 3] * __expf(-tn * dl[e]); cs[e] += fabsf(v);
                            float* kr = KT + (size_t)(o * 512 + c0 + e) * 16384;
                            if (dir == 0) kr[t] = v; else if (t > 0) kr[16384 - t] = v; else KT0B[o * 512 + c0 + e] = v;
                        }
                    }
#pragma unroll
                for (int e = 0; e < 8; ++e) { float s = cs[e]; s += __shfl_xor(s, 1); s += __shfl_xor(s, 2); s += __shfl_xor(s, 4); s += __shfl_xor(s, 8);
                    if (fr == 0) PART[(size_t)(u.pm * 2 + wr) * 2048 + col0 + e] = s; }
            }
            return;
        }
#pragma unroll
        for (int ai = 0; ai < 2; ++ai)
#pragma unroll
            for (int m = 0; m < 4; ++m) {
                const int row = u.pm * BM + ai * HALF + wr * 64 + m * 16 + fr;
#pragma unroll
                for (int bj = 0; bj < 2; ++bj) {
                    const int col = u.pn * BM + bj * HALF + wc * 32 + 8 * fq;
                    f32x4 v0 = acc[ai][bj][m][0], v1 = acc[ai][bj][m][1];
                    if (mode == EP_BF16) {
                        u32x4 w; w.x = cvt_pk_bf16(v0[0], v0[1]); w.y = cvt_pk_bf16(v0[2], v0[3]); w.z = cvt_pk_bf16(v1[0], v1[1]); w.w = cvt_pk_bf16(v1[2], v1[3]);
                        *(u32x4*)((bf16_t*)O + (size_t)row * ldc + col) = w;
                    } else if (mode == EP_RELU2) {
#pragma unroll
                        for (int e = 0; e < 4; ++e) { float a = fmaxf(v0[e], 0.f), b = fmaxf(v1[e], 0.f); v0[e] = a * a; v1[e] = b * b; }
                        u32x4 w; w.x = cvt_pk_bf16(v0[0], v0[1]); w.y = cvt_pk_bf16(v0[2], v0[3]); w.z = cvt_pk_bf16(v1[0], v1[1]); w.w = cvt_pk_bf16(v1[2], v1[3]);
                        *(u32x4*)((bf16_t*)O + (size_t)row * ldc + col) = w;
                    } else if (mode == EP_F32S) {
                        float* o = (float*)O + (size_t)row * ldc + col;
                        *(f32x4*)o = v0 * scale; *(f32x4*)(o + 4) = v1 * scale;
                    } else if (mode == EP_ODDIN) {
                        if (col < 512) {
                            u32x4 w; w.x = cvt_pk_bf16(v0[0], v0[1]); w.y = cvt_pk_bf16(v0[2], v0[3]); w.z = cvt_pk_bf16(v1[0], v1[1]); w.w = cvt_pk_bf16(v1[2], v1[3]);
                            *(u32x4*)((bf16_t*)O + (size_t)row * 512 + col) = w;
                        } else {
                            bf16_t* pt = (bf16_t*)O2 + (size_t)(col - 512) * 16384 + row;
#pragma unroll
                            for (int e = 0; e < 4; ++e) { pt[(size_t)e * 16384] = (bf16_t)(cvt_pk_bf16(v0[e], 0.f) & 0xffffu); pt[(size_t)(e + 4) * 16384] = (bf16_t)(cvt_pk_bf16(v1[e], 0.f) & 0xffffu); }
                        }
                    } else if (mode == EP_VT) {
                        bf16_t* vt = (bf16_t*)O + ((size_t)(row >> 8) * 1024 + col) * 256 + (row & 255);
#pragma unroll
                        for (int e = 0; e < 4; ++e) { vt[(size_t)e * 256] = (bf16_t)(cvt_pk_bf16(v0[e], 0.f) & 0xffffu); vt[(size_t)(e + 4) * 256] = (bf16_t)(cvt_pk_bf16(v1[e], 0.f) & 0xffffu); }
                    } else {
                        const u32x4 gw = *(const u32x4*)((const bf16_t*)aux + (size_t)row * 512 + col);
                        float g[8] = {bfl(gw.x), bfh(gw.x), bfl(gw.y), bfh(gw.y), bfl(gw.z), bfh(gw.z), bfl(gw.w), bfh(gw.w)};
                        float o[8];
#pragma unroll
                        for (int e = 0; e < 4; ++e) { o[e] = g[e] / (1.f + __expf(-v0[e])); o[e + 4] = g[e + 4] / (1.f + __expf(-v1[e])); }
                        u32x4 w; w.x = cvt_pk_bf16(o[0], o[1]); w.y = cvt_pk_bf16(o[2], o[3]); w.z = cvt_pk_bf16(o[4], o[5]); w.w = cvt_pk_bf16(o[6], o[7]);
                        *(u32x4*)((bf16_t*)O + (size_t)row * ldc + col) = w;
                    }
                }
            }
    }
};
template <class Epi, class Sched, bool ALIGN_EPI = false, bool SP2 = false>
__device__ __forceinline__ void gemm_phase(PG8_LAS unsigned char* lds, const Gemm g, const Sched& S, const Epi& E, const int tid) {
    const int wid = __builtin_amdgcn_readfirstlane(tid >> 6), lane = tid & 63, wr = wid >> 2, wc = wid & 3, fr = lane & 15, fq = lane >> 4;
    const int K = g.K, nt = K / BK;
    unsigned voffA[2], voffB[2];
#pragma unroll
    for (int i = 0; i < 2; ++i) { int R, C; stage_rc(tid * 16 + i * 8192, R, C); const int Rb = Epi::PERM ? ((R & ~31) + perm32(R & 31)) : R;
        voffA[i] = (unsigned)(R * g.lda + C) * 2u; voffB[i] = (unsigned)(Rb * g.ldb + C) * 2u; }
    const size_t kstep = (size_t)(BK * 2);
    const size_t hstepA = (size_t)HALF * g.lda * 2, hstepB = (size_t)HALF * g.ldb * 2;
    const unsigned ldsw = (unsigned)wid * 1024u;
    const int aoff = lds_byte(wr * 64 + fr, fq * 8), boff = lds_byte(wc * 32 + fr, fq * 8);
#define PG8_SA(b, h) (((b) * 2 + (h)) * HTB)
#define PG8_SB(b, h) ((4 + (b) * 2 + (h)) * HTB)
#define PG8_STAGE(bufoff, gbase, voff) do { _Pragma("unroll") for (int _i = 0; _i < 2; ++_i) \
        __builtin_amdgcn_global_load_lds((const unsigned*)((const char*)(gbase) + (voff)[_i]), (PG8_LAS unsigned*)(lds + (bufoff) + ldsw + _i * 8192), 16, 0, 0); } while (0)
#define PG8_LDA(dst, b, h) do { _Pragma("unroll") for (int m = 0; m < 4; ++m) _Pragma("unroll") for (int k = 0; k < 2; ++k) dst[m][k] = *(const PG8_LAS bf16x8*)(lds + PG8_SA(b, h) + aoff + m * 2048 + k * 1024); } while (0)
#define PG8_LDB(dst, b, h) do { _Pragma("unroll") for (int n = 0; n < 2; ++n) _Pragma("unroll") for (int k = 0; k < 2; ++k) dst[n][k] = *(const PG8_LAS bf16x8*)(lds + PG8_SB(b, h) + boff + n * 2048 + k * 1024); } while (0)
#define PG8_MMA(ai, bj, At, Bt) do { __builtin_amdgcn_s_setprio(1); _Pragma("unroll") for (int m = 0; m < 4; ++m) _Pragma("unroll") for (int n = 0; n < 2; ++n) _Pragma("unroll") for (int k = 0; k < 2; ++k) \
        acc[ai][bj][m][n] = __builtin_amdgcn_mfma_f32_16x16x32_bf16(Bt[n][k], At[m][k], acc[ai][bj][m][n], 0, 0, 0); __builtin_amdgcn_s_setprio(0); } while (0)
#define PG8_WAIT_V(n) asm volatile("s_waitcnt vmcnt(" #n ")" ::: "memory")
#define PG8_WAIT_L(n) asm volatile("s_waitcnt lgkmcnt(" #n ")" ::: "memory")
#define PG8_BAR __builtin_amdgcn_s_barrier()
#define PG8_SCHED __builtin_amdgcn_sched_barrier(0)
    Unit cur, nxt; int ui = 0;
    if (!S.next(0, cur)) return;
    f32x4 acc[2][2][4][2];
#pragma unroll
    for (int a = 0; a < 2; ++a)
#pragma unroll
        for (int b = 0; b < 2; ++b)
#pragma unroll
            for (int m = 0; m < 4; ++m)
#pragma unroll
                for (int n = 0; n < 2; ++n) acc[a][b][m][n] = (f32x4){0.f, 0.f, 0.f, 0.f};
    bf16x8 At[4][2], B0[2][2], B1[2][2];
    const char* cA = cur.a; const char* cB = cur.b;
    S.a_ready(cur);
    if constexpr (SP2) {
        PG8_STAGE(PG8_SB(0, 0), cB, voffB); PG8_STAGE(PG8_SB(0, 1), cB + hstepB, voffB); PG8_STAGE(PG8_SA(0, 0), cA, voffA); PG8_STAGE(PG8_SA(0, 1), cA + hstepA, voffA);
        if (wr == 1) PG8_BAR;
        PG8_WAIT_V(2); PG8_BAR;
        PG8_STAGE(PG8_SB(1, 0), cB + kstep, voffB); PG8_STAGE(PG8_SA(1, 0), cA + kstep, voffA); PG8_STAGE(PG8_SB(1, 1), cB + hstepB + kstep, voffB);
        PG8_WAIT_V(6); PG8_BAR;
    } else {
        PG8_STAGE(PG8_SB(0, 0), cB, voffB); PG8_STAGE(PG8_SA(0, 0), cA, voffA); PG8_STAGE(PG8_SB(0, 1), cB + hstepB, voffB); PG8_STAGE(PG8_SA(0, 1), cA + hstepA, voffA);
        if (wr == 1) PG8_BAR;
        PG8_WAIT_V(4); PG8_BAR;
        PG8_STAGE(PG8_SB(1, 0), cB + kstep, voffB); PG8_STAGE(PG8_SA(1, 0), cA + kstep, voffA); PG8_STAGE(PG8_SB(1, 1), cB + hstepB + kstep, voffB);
        PG8_WAIT_V(6); PG8_BAR;
    }
    for (;;) {
        const bool has_next = S.next(ui + 1, nxt);
        const char* nA = has_next ? nxt.a : cA; const char* nB = has_next ? nxt.b : cB;
        for (int t = 0; t < nt; t += 2) {
            const bool last = (t == nt - 2);
            const char* a1 = cA + (size_t)(t + 1) * kstep;
            const char* a2 = last ? nA : cA + (size_t)(t + 2) * kstep; const char* b2 = last ? nB : cB + (size_t)(t + 2) * kstep;
            const char* a3 = a2 + kstep; const char* b3 = b2 + kstep;
            if (last && has_next) S.a_ready(nxt);
            if constexpr (SP2) {
            PG8_LDB(B0, 0, 0); PG8_LDB(B1, 0, 1); PG8_SCHED; PG8_LDA(At, 0, 0); PG8_STAGE(PG8_SA(1, 1), a1 + hstepA, voffA);
            PG8_WAIT_V(8); PG8_WAIT_L(0); PG8_BAR; PG8_MMA(0, 0, At, B0); PG8_MMA(0, 1, At, B1); PG8_BAR; PG8_SCHED;
            PG8_LDA(At, 0, 1); PG8_STAGE(PG8_SB(0, 0), b2, voffB); PG8_STAGE(PG8_SB(0, 1), b2 + hstepB, voffB); PG8_STAGE(PG8_SA(0, 0), a2, voffA);
            PG8_WAIT_V(8); PG8_WAIT_L(0); PG8_BAR; PG8_MMA(1, 0, At, B0); PG8_MMA(1, 1, At, B1); PG8_BAR; PG8_SCHED;
            PG8_LDB(B0, 1, 0); PG8_LDB(B1, 1, 1); PG8_SCHED; PG8_LDA(At, 1, 0); PG8_STAGE(PG8_SA(0, 1), a2 + hstepA, voffA);
            PG8_WAIT_V(8); PG8_WAIT_L(0); PG8_BAR; PG8_MMA(0, 0, At, B0); PG8_MMA(0, 1, At, B1); PG8_BAR; PG8_SCHED;
            PG8_LDA(At, 1, 1); PG8_STAGE(PG8_SB(1, 0), b3, voffB); PG8_STAGE(PG8_SB(1, 1), b3 + hstepB, voffB); PG8_STAGE(PG8_SA(1, 0), a3, voffA);
            PG8_WAIT_V(8); PG8_WAIT_L(0); PG8_BAR; PG8_MMA(1, 0, At, B0); PG8_MMA(1, 1, At, B1); PG8_BAR; PG8_SCHED;
            } else {
            PG8_LDB(B0, 0, 0); PG8_SCHED; PG8_LDA(At, 0, 0); PG8_STAGE(PG8_SA(1, 1), a1 + hstepA, voffA);
            PG8_WAIT_L(8); PG8_BAR; PG8_WAIT_L(0); PG8_MMA(0, 0, At, B0); PG8_BAR; PG8_SCHED;
            PG8_LDB(B1, 0, 1); PG8_STAGE(PG8_SB(0, 0), b2, voffB);
            PG8_BAR; PG8_WAIT_L(0); PG8_MMA(0, 1, At, B1); PG8_BAR;
            PG8_LDA(At, 0, 1); PG8_STAGE(PG8_SA(0, 0), a2, voffA);
            PG8_BAR; PG8_WAIT_L(0); PG8_MMA(1, 0, At, B0); PG8_BAR; PG8_SCHED;
            PG8_STAGE(PG8_SB(0, 1), b2 + hstepB, voffB);
            PG8_WAIT_V(6); PG8_BAR; PG8_MMA(1, 1, At, B1); PG8_BAR;
            PG8_LDB(B0, 1, 0); PG8_SCHED; PG8_LDA(At, 1, 0); PG8_STAGE(PG8_SA(0, 1), a2 + hstepA, voffA);
            PG8_WAIT_L(8); PG8_BAR; PG8_WAIT_L(0); PG8_MMA(0, 0, At, B0); PG8_BAR; PG8_SCHED;
            PG8_LDB(B1, 1, 1); PG8_STAGE(PG8_SB(1, 0), b3, voffB);
            PG8_BAR; PG8_WAIT_L(0); PG8_MMA(0, 1, At, B1); PG8_BAR;
            PG8_LDA(At, 1, 1); PG8_STAGE(PG8_SA(1, 0), a3, voffA);
            PG8_BAR; PG8_WAIT_L(0); PG8_MMA(1, 0, At, B0); PG8_BAR; PG8_SCHED;
            PG8_STAGE(PG8_SB(1, 1), b3 + hstepB, voffB);
            PG8_WAIT_V(6); PG8_BAR; PG8_MMA(1, 1, At, B1); PG8_BAR;
            }
        }
        if constexpr (ALIGN_EPI) { if (wr == 0) PG8_BAR; }
        if constexpr (!Epi::AFTER_DRAIN) { E(acc, cur, wr, wc, fr, fq); S.done(cur); }
        if (!has_next) break;
#pragma unroll
        for (int a = 0; a < 2; ++a)
#pragma unroll
            for (int b = 0; b < 2; ++b)
#pragma unroll
                for (int m = 0; m < 4; ++m)
#pragma unroll
                    for (int n = 0; n < 2; ++n) acc[a][b][m][n] = (f32x4){0.f, 0.f, 0.f, 0.f};
        cur = nxt; cA = nA; cB = nB; ++ui;
        if constexpr (ALIGN_EPI) { if (wr == 1) PG8_BAR; }
    }
    PG8_WAIT_V(0);
    if constexpr (!ALIGN_EPI) { if (wr == 0) PG8_BAR; }
    PG8_BAR;
    if constexpr (Epi::AFTER_DRAIN) { E.fused(acc, cur, wr, wc, fr, fq, lds, wid, lane); S.done(cur); }
#undef PG8_SA
#undef PG8_SB
#undef PG8_STAGE
#undef PG8_LDA
#undef PG8_LDB
#undef PG8_MMA
#undef PG8_WAIT_V
#undef PG8_WAIT_L
#undef PG8_BAR
#undef PG8_SCHED
}
}

typedef unsigned short bf16;
typedef float f32x4 __attribute__((ext_vector_type(4)));
typedef unsigned u32x4 __attribute__((ext_vector_type(4)));
typedef unsigned u32x2 __attribute__((ext_vector_type(2)));
constexpr int L_SEQ = 8192, T_TOK = 16384, D = 1024, FF = 4096, NMEMT = 512;
constexpr int NFFT = 16384;
constexpr float RMS_EPS = 1e-6f;
constexpr int LDS_BYTES = 155648;
constexpr size_t MiB = 1u << 20;
constexpr size_t WS_NORMS = 0;
constexpr size_t WS_KT0B = 8192;
constexpr size_t WS_BAR = 16384, WS_BAR_BYTES = 16384;
constexpr size_t WS_TW = 65536;
constexpr size_t WS_S5F = 1 * MiB;
constexpr size_t WS_H2 = 4 * MiB;
constexpr size_t WS_MN = 6 * MiB;
constexpr size_t WS_KB = 7 * MiB;
constexpr size_t WS_VT = 8 * MiB;
constexpr size_t WS_PART = 9 * MiB;
constexpr size_t WS_W = 16 * MiB;
constexpr size_t W_IN = 0, W_OUT = 4 * MiB, W_Q = 6 * MiB, W_K = 8 * MiB, W_V = 10 * MiB, W_O = 12 * MiB, W_1 = 14 * MiB, W_2 = 22 * MiB, W_GLU = 30 * MiB, W_3T = 31 * MiB;
constexpr size_t WS_HN = 48 * MiB;
constexpr size_t WS_MIXOUT = 80 * MiB;
constexpr size_t WS_MIXIN = 112 * MiB;
constexpr size_t WS_R = 144 * MiB;
constexpr size_t R_P = 0;
constexpr size_t R_Q = 0, R_SC = 32 * MiB, R_PROB = 96 * MiB;
constexpr size_t R_H = 0;
constexpr size_t R_SPEC = 0, R_KT = 64 * MiB, R_PT = 64 * MiB, R_Y = 64 * MiB, R_PS5 = 112 * MiB, R_G = 128 * MiB, R_YT = 144 * MiB;
constexpr size_t WS_END = WS_R + 160 * MiB;

struct Args { const float* in[37]; float* out; unsigned char* ws; };
constexpr int TAB_OFF = LDS_BYTES - 512;
__device__ __forceinline__ const void* ldptr(const unsigned char* lds, int i) {
    const volatile unsigned* p = (const volatile unsigned*)(lds + TAB_OFF) + 2 * i;
    const unsigned lo = __builtin_amdgcn_readfirstlane(p[0]), hi = __builtin_amdgcn_readfirstlane(p[1]);
    return (const void*)(((unsigned long long)hi << 32) | lo);
}

__device__ __forceinline__ float bf2f(bf16 v) { return __uint_as_float((unsigned)v << 16); }
__device__ __forceinline__ unsigned f2bf(float f) { unsigned u = __float_as_uint(f); return (u + 0x7fffu + ((u >> 16) & 1u)) >> 16; }
__device__ __forceinline__ unsigned pk2(float lo, float hi) { return f2bf(lo) | (f2bf(hi) << 16); }
__device__ __forceinline__ float wave_sum(float v) {
#pragma unroll
    for (int o = 1; o < 64; o <<= 1) v += __shfl_xor(v, o);
    return v;
}
__device__ __forceinline__ float wave_max(float v) {
#pragma unroll
    for (int o = 1; o < 64; o <<= 1) v = fmaxf(v, __shfl_xor(v, o));
    return v;
}
#define XB_TMO      128
#define XB_XCNT(j)  (256  + 64 * (j))
#define XB_XSUB(j)  (1280 + 64 * (j))
#define XB_XGEN(j)  (2304 + 64 * (j))
#define XB_TOP      3328
#define XB_TOPGEN   3392
#define XCD_BAR_WORDS 3456
#define XB_SPIN_CAP (1u << 18)

__device__ __forceinline__ unsigned xb_ld(unsigned* p)              { return __hip_atomic_load(p, __ATOMIC_RELAXED, __HIP_MEMORY_SCOPE_AGENT); }
__device__ __forceinline__ unsigned xb_add(unsigned* p, unsigned v) { return __hip_atomic_fetch_add(p, v, __ATOMIC_RELAXED, __HIP_MEMORY_SCOPE_AGENT); }
__device__ __forceinline__ unsigned xb_xcc_id() { return (unsigned)__builtin_amdgcn_s_getreg((3 << 11) | 20) & 0xFu; }
#define XB_SPIN(cond, bar) do { unsigned _sp = 0; while (cond) { __builtin_amdgcn_s_sleep(1); \
    if ((++_sp & 255u) == 0u) { if (xb_ld(&(bar)[XB_TMO])) break; if (_sp > XB_SPIN_CAP) { atomicAdd(&(bar)[XB_TMO], 1u); break; } } } } while (0)

struct XcdBarrier {
    unsigned* bar; unsigned x;
    volatile __attribute__((address_space(3))) unsigned* st;
};

__device__ __forceinline__ XcdBarrier xcd_barrier_post(unsigned* bar, volatile __attribute__((address_space(3))) unsigned* st) {
    XcdBarrier b; b.bar = bar; b.x = xb_xcc_id(); b.st = st;
    if (threadIdx.x == 0) (void)xb_add(&bar[XB_XCNT(b.x)], 1u);
    return b;
}
__device__ __forceinline__ void xcd_barrier_complete(unsigned* bar, unsigned x, unsigned& nloc, unsigned& nx) {
    const unsigned G = gridDim.x * gridDim.y * gridDim.z;
    unsigned sum, cnt, mine, sp = 0u;
    for (;;) {
        sum = 0u; cnt = 0u; mine = 0u;
#pragma unroll
        for (unsigned j = 0; j < 16; ++j) { const unsigned c = xb_ld(&bar[XB_XCNT(j)]); sum += c; cnt += (c > 0u) ? 1u : 0u; mine = (j == x) ? c : mine; }
        if (sum == G) break;
        __builtin_amdgcn_s_sleep(1);
        if ((++sp & 255u) == 0u) { if (xb_ld(&bar[XB_TMO])) break; if (sp > XB_SPIN_CAP) { atomicAdd(&bar[XB_TMO], 1u); break; } }
    }
    nloc = mine > 0u ? mine : 1u; nx = cnt > 0u ? cnt : 1u;
}

__device__ __forceinline__ void xcd_barrier(const XcdBarrier& b) {
    asm volatile("s_waitcnt vmcnt(0)" ::: "memory");
    __syncthreads();
    if (threadIdx.x == 0) {
        unsigned* bar = b.bar;
        __builtin_amdgcn_s_waitcnt(0);
        unsigned nloc = b.st[0], nx = b.st[1];
        if (nloc == 0u) { xcd_barrier_complete(bar, b.x, nloc, nx); b.st[0] = nloc; b.st[1] = nx; }
        const unsigned old = xb_add(&bar[XB_XSUB(b.x)], 1u);
        const unsigned gen = old / nloc;
        if (old + 1u == (gen + 1u) * nloc) {
            __builtin_amdgcn_fence(__ATOMIC_RELEASE, "agent");
            asm volatile("s_waitcnt vmcnt(0)" ::: "memory");
            const unsigned og = xb_add(&bar[XB_TOP], 1u);
            const unsigned tg = og / nx;
            if (og + 1u == (tg + 1u) * nx) xb_add(&bar[XB_TOPGEN], 1u);
            else XB_SPIN(xb_ld(&bar[XB_TOPGEN]) == tg, bar);
            __builtin_amdgcn_fence(__ATOMIC_ACQUIRE, "agent");
            xb_add(&bar[XB_XGEN(b.x)], 1u);
            asm volatile("s_waitcnt vmcnt(0)" ::: "memory");
        } else {
            XB_SPIN(xb_ld(&bar[XB_XGEN(b.x)]) == gen, bar);
            __builtin_amdgcn_fence(__ATOMIC_ACQUIRE, "agent");
            asm volatile("s_waitcnt vmcnt(0)" ::: "memory");
        }
    }
    __syncthreads();
}

#define LDS_FENCE() asm volatile("s_waitcnt lgkmcnt(0)" ::: "memory")

__device__ __forceinline__ void transpose_item(const float* W, int ldw, int ncols, bf16* WT, int ldt, float* scr, int item, int lane) {
    const int nblk = ncols / 32, kb = item / nblk, nb = item % nblk, k0 = 64 * kb, n0 = 32 * nb;
#pragma unroll 8
    for (int i = 0; i < 32; ++i) { const int kk = 2 * i + (lane >> 5); scr[kk * 33 + (lane & 31)] = W[(size_t)(k0 + kk) * ldw + n0 + (lane & 31)]; }
    LDS_FENCE();
    const int c = lane & 7;
#pragma unroll
    for (int j = 0; j < 4; ++j) { const int n = (lane >> 3) + 8 * j; const float* s = scr + (8 * c) * 33 + n;
        u32x4 o; o.x = pk2(s[0 * 33], s[1 * 33]); o.y = pk2(s[2 * 33], s[3 * 33]); o.z = pk2(s[4 * 33], s[5 * 33]); o.w = pk2(s[6 * 33], s[7 * 33]);
        *(u32x4*)(WT + (size_t)(n0 + n) * ldt + k0 + 8 * c) = o; }
    LDS_FENCE();
}

__device__ __forceinline__ void norm_row(const float* xin, float* xout, const bf16* br, const float* gpost, const float* gpre, bf16* hn, int lane) {
    f32x4 v[4];
#pragma unroll
    for (int j = 0; j < 4; ++j) v[j] = *((const f32x4*)xin + lane + 64 * j);
    if (br) {
        f32x4 r[4]; float ss = 0.f;
#pragma unroll
        for (int j = 0; j < 4; ++j) { const u32x2 w = *((const u32x2*)br + lane + 64 * j);
            r[j] = (f32x4){pg8::bfl(w.x), pg8::bfh(w.x), pg8::bfl(w.y), pg8::bfh(w.y)}; ss += (r[j].x * r[j].x + r[j].y * r[j].y) + (r[j].z * r[j].z + r[j].w * r[j].w); }
        const float rstd = rsqrtf(wave_sum(ss) * (1.f / D) + RMS_EPS);
#pragma unroll
        for (int j = 0; j < 4; ++j) { const f32x4 g = *((const f32x4*)gpost + lane + 64 * j); v[j] = v[j] + r[j] * rstd * g; }
    }
    if (xout) {
#pragma unroll
        for (int j = 0; j < 4; ++j) *((f32x4*)xout + lane + 64 * j) = v[j];
    }
    if (hn) {
        float ss = 0.f;
#pragma unroll
        for (int j = 0; j < 4; ++j) ss += (v[j].x * v[j].x + v[j].y * v[j].y) + (v[j].z * v[j].z + v[j].w * v[j].w);
        const float rstd = rsqrtf(wave_sum(ss) * (1.f / D) + RMS_EPS);
#pragma unroll
        for (int j = 0; j < 4; ++j) { const f32x4 g = *((const f32x4*)gpre + lane + 64 * j); const f32x4 o = v[j] * rstd * g;
            u32x2 w; w.x = pk2(o.x, o.y); w.y = pk2(o.z, o.w); *((u32x2*)hn + lane + 64 * j) = w; }
    }
}

#define PADI(i) ((i) + (((i) >> 6) << 2))
constexpr int FFT_LDS_ELEMS = 16384 + 1024;
constexpr int TWL_OFF = FFT_LDS_ELEMS * 8;
__device__ __forceinline__ float2 cmul(float2 a, float2 b) { return make_float2(a.x * b.x - a.y * b.y, a.x * b.y + a.y * b.x); }
__device__ __forceinline__ float2 cmulc(float2 a, float2 b) { return make_float2(a.x * b.x + a.y * b.y, a.y * b.x - a.x * b.y); }
template <bool INV> __device__ __forceinline__ void fft16(float2 (&r)[16]) {
    const float C[8] = {1.f, 0.9238795325112867f, 0.7071067811865476f, 0.3826834323650898f, 0.f, -0.3826834323650898f, -0.7071067811865476f, -0.9238795325112867f};
    const float S[8] = {0.f, 0.3826834323650898f, 0.7071067811865476f, 0.9238795325112867f, 1.f, 0.9238795325112867f, 0.7071067811865476f, 0.3826834323650898f};
#pragma unroll
    for (int st = 0; st < 4; ++st) {
        const int ls = INV ? st : 3 - st, s = 1 << ls;
#pragma unroll
        for (int b = 0; b < 8; ++b) {
            const int off = b & (s - 1), i = ((b >> ls) << (ls + 1)) + off, k = off << (3 - ls);
            const float2 a = r[i], c = r[i + s];
            if (!INV) {
                const float2 d = make_float2(a.x - c.x, a.y - c.y);
                r[i] = make_float2(a.x + c.x, a.y + c.y);
                if (k == 0) r[i + s] = d; else if (k == 4) r[i + s] = make_float2(d.y, -d.x); else r[i + s] = cmul(d, make_float2(C[k], -S[k]));
            } else {
                float2 bb; if (k == 0) bb = c; else if (k == 4) bb = make_float2(-c.y, c.x); else bb = cmulc(c, make_float2(C[k], -S[k]));
                r[i] = make_float2(a.x + bb.x, a.y + bb.y); r[i + s] = make_float2(a.x - bb.x, a.y - bb.y);
            }
        }
    }
}
template <bool INV, int LSM> __device__ __forceinline__ void fft_pass16(float2* x, const float2* twl, int tid) {
    constexpr int SH = 10 - LSM;
    constexpr int QS = (LSM >= 6) ? ((1 << LSM) + ((1 << LSM) >> 4)) : (1 << LSM);
#pragma unroll 1
    for (int w = tid; w < 1024; w += 512) {
        const int j = w & ((1 << LSM) - 1), base = (w >> LSM) << (LSM + 4);
        float2* px = x + PADI(base + j);
        float2 r[16];
#pragma unroll
        for (int q = 0; q < 16; ++q) r[q] = px[q * QS];
        const float2 th = twl[j << SH];
        float2 pw[16];
        pw[1] = th; pw[2] = cmul(th, th); pw[3] = cmul(pw[2], th); pw[4] = cmul(pw[2], pw[2]); pw[5] = cmul(pw[4], th); pw[6] = cmul(pw[3], pw[3]); pw[7] = cmul(pw[6], th);
        pw[8] = cmul(pw[4], pw[4]); pw[9] = cmul(pw[8], th); pw[10] = cmul(pw[5], pw[5]); pw[11] = cmul(pw[10], th); pw[12] = cmul(pw[6], pw[6]); pw[13] = cmul(pw[12], th); pw[14] = cmul(pw[7], pw[7]); pw[15] = cmul(pw[14], th);
        if (!INV) fft16<false>(r);
#pragma unroll
        for (int p = 1; p < 16; ++p) { const int br = ((p & 1) << 3) | ((p & 2) << 1) | ((p & 4) >> 1) | ((p & 8) >> 3); r[p] = INV ? cmulc(r[p], pw[br]) : cmul(r[p], pw[br]); }
        if (INV) fft16<true>(r);
#pragma unroll
        for (int q = 0; q < 16; ++q) px[q * QS] = r[q];
    }
    __syncthreads();
}
template <bool INV> __device__ __forceinline__ void fft_pass4(float2* x, int tid) {
#pragma unroll 2
    for (int w = tid; w < 4096; w += 512) {
        float4* p = (float4*)(x + PADI(4 * w));
        const float4 v01 = p[0], v23 = p[1];
        const float2 r0 = make_float2(v01.x, v01.y), r1 = make_float2(v01.z, v01.w), r2 = make_float2(v23.x, v23.y), r3 = make_float2(v23.z, v23.w);
        if (!INV) {
            const float2 a0 = make_float2(r0.x + r2.x, r0.y + r2.y), a2 = make_float2(r0.x - r2.x, r0.y - r2.y), a1 = make_float2(r1.x + r3.x, r1.y + r3.y), d = make_float2(r1.x - r3.x, r1.y - r3.y);
            const float2 a3 = make_float2(d.y, -d.x);
            p[0] = make_float4(a0.x + a1.x, a0.y + a1.y, a0.x - a1.x, a0.y - a1.y); p[1] = make_float4(a2.x + a3.x, a2.y + a3.y, a2.x - a3.x, a2.y - a3.y);
        } else {
            const float2 a0 = make_float2(r0.x + r1.x, r0.y + r1.y), a1 = make_float2(r0.x - r1.x, r0.y - r1.y), a2 = make_float2(r2.x + r3.x, r2.y + r3.y), a3 = make_float2(r2.x - r3.x, r2.y - r3.y);
            const float2 b = make_float2(-a3.y, a3.x);
            p[0] = make_float4(a0.x + a2.x, a0.y + a2.y, a1.x + b.x, a1.y + b.y); p[1] = make_float4(a0.x - a2.x, a0.y - a2.y, a1.x - b.x, a1.y - b.y);
        }
    }
    __syncthreads();
}
__device__ __forceinline__ void fft_fwd(float2* x, const float2* twl, int tid) { fft_pass16<false, 10>(x, twl, tid); fft_pass16<false, 6>(x, twl, tid); fft_pass16<false, 2>(x, twl, tid); fft_pass4<false>(x, tid); }
__device__ __forceinline__ void fft_inv(float2* x, const float2* twl, int tid) { fft_pass4<true>(x, tid); fft_pass16<true, 2>(x, twl, tid); fft_pass16<true, 6>(x, twl, tid); fft_pass16<true, 10>(x, twl, tid); }
__device__ __forceinline__ void spec_mul(float2* x, const unsigned* __restrict__ sp, int tid) {
    for (int p = tid; p < NFFT; p += 512) { const unsigned w = sp[p]; const float kr = pg8::bfl(w), ki = pg8::bfh(w); const float2 a = x[PADI(p)]; x[PADI(p)] = make_float2(a.x * kr - a.y * ki, a.x * ki + a.y * kr); }
    __syncthreads();
}
__device__ __forceinline__ float hy_sc(const bf16* r, int t, float w0, float w1, float w2, float sb) {
    const float a = bf2f(r[max(t - 1, 0)]), b = bf2f(r[t]), c = bf2f(r[min(t + 1, L_SEQ - 1)]);
    return sb + w1 * b + (t > 0 ? w0 * a : 0.f) + (t < L_SEQ - 1 ? w2 * c : 0.f);
}
__device__ __forceinline__ float gelu_tanh(float x) { const float u = 0.7978845608028654f * (x + 0.044715f * x * x * x); return 0.5f * x * (1.f + tanhf(u)); }


typedef short bf16x8_t __attribute__((ext_vector_type(8)));
template <bool PASSB>
__device__ __forceinline__ void s5_pass(unsigned char* lds, int tid, int bid, int G, const bf16* PS5, float2* S5F, float* Y, bf16* Gb,
        const float* lam_re, const float* lam_im, const float* log_dt, const float* b_re, const float* b_im, const float* c_re, const float* c_im, const float* dskp) {
    const int lane = tid & 63, wave = __builtin_amdgcn_readfirstlane(tid >> 6), l15 = lane & 15, lq = lane >> 4, n = lane;
    float2* CL = (float2*)lds;
    float2* BUs = (float2*)(lds + 16384) + wave * (16 * 65);
    bf16* Sb = (bf16*)(lds + 16384 + 8 * 16 * 65 * 8) + wave * (16 * 136);
    for (int bt = bid; bt < 256; bt += G) {
        const int bgi = bt & 63, b = bgi >> 5, gq = bgi & 31, chunk = (bt >> 6) * 8 + wave;
        if (PASSB) {
            __syncthreads();
            for (int e = tid; e < 2048; e += 512) { const int d = e >> 10, nn = (e >> 4) & 63, h = e & 15;
                const size_t li = ((size_t)d * 32 + gq) * 64 + nn;
                const float lr = fminf(lam_re[li], -1e-4f), lim = lam_im[li], dtv = expf(log_dt[d * 32 + gq]);
                const float mag = expf(lr * dtv); float sn, cs; sincosf(lim * dtv, &sn, &cs); const float ar = mag * cs - 1.f, ai = mag * sn;
                const float den = 1.f / (lr * lr + lim * lim); const float cr = (ar * lr + ai * lim) * den, ci = (ai * lr - ar * lim) * den;
                const size_t cidx = (((size_t)d * 32 + gq) * 16 + h) * 64 + nn; const float xr = c_re[cidx], xi = c_im[cidx];
                CL[e] = make_float2(xr * cr - xi * ci, xr * ci + xi * cr); }
            __syncthreads();
        }
        bf16x8_t Bf[8];
#pragma unroll
        for (int f = 0; f < 8; ++f) { const float* src = ((f < 4) ? b_re : b_im) + ((size_t)gq * 64 + 16 * (f & 3) + l15) * 16 + 8 * (lq & 1);
            const f32x4 v0 = *(const f32x4*)src, v1 = *(const f32x4*)(src + 4);
            u32x4 w; w.x = pk2(v0.x, v0.y); w.y = pk2(v0.z, v0.w); w.z = pk2(v1.x, v1.y); w.w = pk2(v1.z, v1.w);
            if (lq >= 2) w = (u32x4){0u, 0u, 0u, 0u};
            Bf[f] = __builtin_bit_cast(bf16x8_t, w); }
        const float dsk = PASSB ? dskp[gq * 16 + l15] : 0.f;
        const size_t rowc = (size_t)b * L_SEQ + chunk * 256;
        for (int d = 0; d < 2; ++d) {
            const size_t li = ((size_t)d * 32 + gq) * 64 + n;
            const float lr = fminf(lam_re[li], -1e-4f), lim = lam_im[li], dtv = expf(log_dt[d * 32 + gq]);
            const float mag = expf(lr * dtv); float sn, cs; sincosf(lim * dtv, &sn, &cs); const float ar = mag * cs, ai = mag * sn;
            float sr = 0.f, si = 0.f;
            bf16x8_t Cf[4];
            if (PASSB) {
                float pr_ = ar, pi_ = ai;
#pragma unroll
                for (int q = 0; q < 8; ++q) { const float t0 = pr_ * pr_ - pi_ * pi_, t1 = 2.f * pr_ * pi_; pr_ = t0; pi_ = t1; }
                const float2* Fb = S5F + ((((size_t)d * 2 + b) * 32 + gq) * 32) * 64 + n;
                if (d == 0) { for (int cc = 0; cc < chunk; ++cc) { const float2 f = Fb[(size_t)cc * 64]; const float nr = pr_ * sr - pi_ * si + f.x, ni = pr_ * si + pi_ * sr + f.y; sr = nr; si = ni; } }
                else { for (int cc = 31; cc > chunk; --cc) { const float2 f = Fb[(size_t)cc * 64]; const float nr = pr_ * sr - pi_ * si + f.x, ni = pr_ * si + pi_ * sr + f.y; sr = nr; si = ni; } }
#pragma unroll
                for (int kk = 0; kk < 4; ++kk) { float cv[8];
#pragma unroll
                    for (int j = 0; j < 8; ++j) { const int nn = (32 * kk + 8 * lq + j) & 63; const float2 c = CL[d * 1024 + nn * 16 + l15]; cv[j] = (kk < 2) ? c.x : -c.y; }
                    u32x4 w; w.x = pk2(cv[0], cv[1]); w.y = pk2(cv[2], cv[3]); w.z = pk2(cv[4], cv[5]); w.w = pk2(cv[6], cv[7]);
                    Cf[kk] = __builtin_bit_cast(bf16x8_t, w); }
            }
            const bf16* ua = PS5 + (rowc + l15) * 512 + gq * 16 + 8 * (lq & 1);
            u32x4 aN = *(const u32x4*)(ua + (size_t)(d ? 15 : 0) * 16 * 512);
#pragma unroll 1
            for (int s_ = 0; s_ < 16; ++s_) {
                const int sc = d ? 15 - s_ : s_;
                u32x4 aC = aN; if (lq >= 2) aC = (u32x4){0u, 0u, 0u, 0u};
                if (s_ < 15) aN = *(const u32x4*)(ua + (size_t)(d ? sc - 1 : sc + 1) * 16 * 512);
                const bf16x8_t af = __builtin_bit_cast(bf16x8_t, aC);
                f32x4 acc[8];
#pragma unroll
                for (int f = 0; f < 8; ++f) acc[f] = __builtin_amdgcn_mfma_f32_16x16x32_bf16(af, Bf[f], (f32x4){0.f, 0.f, 0.f, 0.f}, 0, 0, 0);
#pragma unroll
                for (int i = 0; i < 4; ++i)
#pragma unroll
                    for (int f = 0; f < 4; ++f) BUs[(4 * lq + i) * 65 + 16 * f + l15] = make_float2(acc[f][i], acc[f + 4][i]);
                LDS_FENCE();
#pragma unroll
                for (int ii = 0; ii < 16; ++ii) { const int i = d ? 15 - ii : ii; const float2 bu = BUs[i * 65 + n];
                    const float nr = ar * sr - ai * si + bu.x, ni = ar * si + ai * sr + bu.y; sr = nr; si = ni;
                    if (PASSB) { Sb[i * 136 + n] = (bf16)f2bf(sr); Sb[i * 136 + 64 + n] = (bf16)f2bf(si); } }
                if (PASSB) {
                    LDS_FENCE();
                    f32x4 y = (f32x4){0.f, 0.f, 0.f, 0.f};
#pragma unroll
                    for (int kk = 0; kk < 4; ++kk) { const bf16x8_t sf = *(const bf16x8_t*)(Sb + l15 * 136 + 32 * kk + 8 * lq); y = __builtin_amdgcn_mfma_f32_16x16x32_bf16(sf, Cf[kk], y, 0, 0, 0); }
#pragma unroll
                    for (int i = 0; i < 4; ++i) { const size_t row = rowc + 16 * sc + 4 * lq + i; float* yp = Y + row * 512 + gq * 16 + l15;
                        if (d == 0) *yp = y[i];
                        else { const float v = *yp + y[i] + dsk * bf2f(PS5[row * 512 + gq * 16 + l15]); Gb[row * 512 + gq * 16 + l15] = (bf16)f2bf(gelu_tanh(v)); } }
                }
                LDS_FENCE();
            }
            if (!PASSB) S5F[((((size_t)d * 2 + b) * 32 + gq) * 32 + chunk) * 64 + n] = make_float2(sr, si);
        }
    }
}

enum { OP_CONVERT = 0, OP_F2, OP_F3, OP_GEMM_K, OP_GEMM_V, OP_GEMM_IN, OP_MIX1, OP_MIX2, OP_GEMM_GLU, OP_GEMM_OUT, OP_NORM_MIX, OP_GEMM_Q, OP_GEMM_S, OP_SOFTMAX, OP_GEMM_PV,
       OP_GEMM_O, OP_NORM_XA, OP_GEMM_UP, OP_GEMM_DOWN, OP_NORM_MLP, OP_COUNT };

__global__ void __launch_bounds__(512, 2) fwd_kernel(Args args) {
    extern __shared__ __attribute__((aligned(16))) unsigned char lds[];
    cg::grid_group grid = cg::this_grid();
#define GRID_SYNC() do { xcd_barrier(xbar); } while (0)
    { const int tid = threadIdx.x;
    if (tid < 37) ((unsigned long long*)(lds + TAB_OFF))[tid] = (unsigned long long)args.in[tid];
    if (tid == 37) ((unsigned long long*)(lds + TAB_OFF))[37] = (unsigned long long)args.out;
    if (tid == 38) ((unsigned long long*)(lds + TAB_OFF))[38] = (unsigned long long)args.ws;
      if (tid == 40 || tid == 41) ((unsigned*)(lds + TAB_OFF + 384))[tid - 40] = 0u; }
    __syncthreads();
    XcdBarrier xbar = xcd_barrier_post((unsigned*)(args.ws + WS_BAR), (volatile __attribute__((address_space(3))) unsigned*)(lds + TAB_OFF + 384));
    asm volatile("s_waitcnt vmcnt(0) lgkmcnt(0)" ::: "memory"); __syncthreads(); grid.sync();
#define INP(i) ((const float*)ldptr(lds, (i)))
    for (int layer_ = 0; layer_ < 4; ++layer_) {
#ifndef REPEAT_MASK
#define REPEAT_MASK 0u
#endif
        for (int opi = 0; opi < OP_COUNT * 2; ++opi) {
            const int op = opi >> 1;
            if ((opi & 1) && !((REPEAT_MASK >> op) & 1u)) continue;
            int tid = threadIdx.x; asm volatile("" : "+v"(tid));
            int bid = blockIdx.x; asm volatile("" : "+s"(bid));
            int G = gridDim.x; asm volatile("" : "+s"(G));
            int layer = layer_; asm volatile("" : "+s"(layer));
            const int lane = tid & 63, wave = __builtin_amdgcn_readfirstlane(tid >> 6);
            const int gw = bid * 8 + wave, NGW = G * 8, gt = bid * 512 + tid, GT = G * 512;
            const int jj = layer >> 1; const bool odd = (layer & 1) != 0;
            unsigned char* ws = (unsigned char*)ldptr(lds, 38);
            float* X = (float*)ldptr(lds, 37);
            float* KT0B = (float*)(ws + WS_KT0B); float2* TW = (float2*)(ws + WS_TW);
            float2* S5F = (float2*)(ws + WS_S5F); float* H2 = (float*)(ws + WS_H2);
            bf16* MN = (bf16*)(ws + WS_MN); bf16* KB = (bf16*)(ws + WS_KB); bf16* VT = (bf16*)(ws + WS_VT);
            unsigned char* WB = ws + WS_W;
            bf16* HN = (bf16*)(ws + WS_HN); bf16* MIXOUT = (bf16*)(ws + WS_MIXOUT); bf16* MIXIN = (bf16*)(ws + WS_MIXIN);
            unsigned char* R = ws + WS_R;

            bool do_sync = true;
            pg8::Gemm g{0, 0, 0}; pg8::Sched S{}; pg8::EpiRT E{}; bool is_gemm = false;
            S.G = G; S.c = bid; S.sa_n = 0; S.sb_b = 0;
            auto setg = [&](const void* A, int lda, const void* Bt, int ldb, int M, int N, int K) {
                g.K = K; g.lda = lda; g.ldb = ldb; S.nM = M / 256; S.nN = N / 256; S.nwg = S.nM * S.nN; S.A = (const char*)A; S.Bt = (const char*)Bt;
                S.sa_m = (size_t)256 * lda * 2; S.sb_n = (size_t)256 * ldb * 2; is_gemm = true; };
            switch (op) {
            case OP_F2: if (odd) { setg(H2, 128, WB + W_3T, 128, L_SEQ, 2048, 128); E.mode = pg8::EP_F2; E.O = R + R_KT; E.O2 = KT0B; E.aux = ws + WS_PART; } break;
            case OP_GEMM_K: setg(MN, D, WB + W_K, D, NMEMT, D, D); E.mode = pg8::EP_BF16; E.O = KB; E.ldc = D; do_sync = false; break;
            case OP_GEMM_V: setg(MN, D, WB + W_V, D, NMEMT, D, D); E.mode = pg8::EP_VT; E.O = VT; do_sync = false; break;
            case OP_GEMM_IN: setg(HN, D, WB + W_IN, D, T_TOK, 2048, D);
                if (!odd) { E.mode = pg8::EP_BF16; E.O = R + R_P; E.ldc = 2048; } else { E.mode = pg8::EP_ODDIN; E.O = R + R_PS5; E.O2 = R + R_PT; } break;
            case OP_GEMM_GLU: if (odd) { setg(R + R_G, 512, WB + W_GLU, 512, T_TOK, 512, 512); E.mode = pg8::EP_GLU; E.O = MIXIN; E.ldc = D; E.aux = R + R_G; } break;
            case OP_GEMM_OUT: setg(MIXIN, D, WB + W_OUT, D, T_TOK, D, D); E.mode = pg8::EP_BF16; E.O = MIXOUT; E.ldc = D; break;
            case OP_GEMM_Q: setg(HN, D, WB + W_Q, D, T_TOK, D, D); E.mode = pg8::EP_BF16; E.O = R + R_Q; E.ldc = D; break;
            case OP_GEMM_S: setg(R + R_Q, D, KB, D, T_TOK, D, 256); S.sa_n = 512; S.sb_n = 512; S.sb_b = (size_t)256 * D * 2;
                E.mode = pg8::EP_F32S; E.O = R + R_SC; E.ldc = D; E.scale = 0.0625f; break;
            case OP_GEMM_PV: setg(R + R_PROB, D, VT, 256, T_TOK, D, 256); S.sa_n = 512; S.sb_n = (size_t)256 * 256 * 2; S.sb_b = (size_t)1024 * 256 * 2;
                E.mode = pg8::EP_BF16; E.O = R + R_Q; E.ldc = D; break;
            case OP_GEMM_O: setg(R + R_Q, D, WB + W_O, D, T_TOK, D, D); E.mode = pg8::EP_BF16; E.O = MIXOUT; E.ldc = D; break;
            case OP_GEMM_UP: setg(HN, D, WB + W_1, D, T_TOK, FF, D); E.mode = pg8::EP_RELU2; E.O = R + R_H; E.ldc = FF; break;
            case OP_GEMM_DOWN: setg(R + R_H, FF, WB + W_2, FF, T_TOK, D, FF); E.mode = pg8::EP_BF16; E.O = MIXOUT; E.ldc = D; break;
            default: break;
            }
            if (is_gemm) {
                pg8::gemm_phase<pg8::EpiRT, pg8::Sched, true, true>((PG8_LAS unsigned char*)lds, g, S, E, tid);
                __syncthreads();
                if (do_sync) GRID_SYNC();
                continue;
            }
            if (op == OP_CONVERT) {
                float* scr = (float*)(lds + wave * 16384);
                const float* Win = odd ? INP(17) + (size_t)jj * D * 2048 : INP(12) + (size_t)jj * D * 2048;
                const float* Wout = odd ? INP(36) + (size_t)jj * D * D : INP(16) + (size_t)jj * D * D;
                const int inc0 = odd ? 0 : 512;
                const int I_IN = (D / 64) * ((2048 - inc0) / 32), I_SQ = (D / 64) * (D / 32), I_1 = (D / 64) * (FF / 32), I_2 = (FF / 64) * (D / 32), I_GLU = odd ? (512 / 64) * (512 / 32) : 0, I_W3 = odd ? 64 : 0;
                const int NIT = I_IN + 5 * I_SQ + I_1 + I_2 + I_GLU + I_W3;
                for (int it = gw; it < NIT; it += NGW) {
                    int r = it;
                    if (r < I_IN) { transpose_item(Win + inc0, 2048, 2048 - inc0, (bf16*)(WB + W_IN) + (size_t)inc0 * D, D, scr, r, lane); continue; } r -= I_IN;
                    if (r < I_SQ) { transpose_item(Wout, D, D, (bf16*)(WB + W_OUT), D, scr, r, lane); continue; } r -= I_SQ;
                    if (r < I_SQ) { transpose_item(INP(6) + (size_t)layer * D * D, D, D, (bf16*)(WB + W_Q), D, scr, r, lane); continue; } r -= I_SQ;
                    if (r < I_SQ) { transpose_item(INP(7) + (size_t)layer * D * D, D, D, (bf16*)(WB + W_K), D, scr, r, lane); continue; } r -= I_SQ;
                    if (r < I_SQ) { transpose_item(INP(8) + (size_t)layer * D * D, D, D, (bf16*)(WB + W_V), D, scr, r, lane); continue; } r -= I_SQ;
                    if (r < I_SQ) { transpose_item(INP(9) + (size_t)layer * D * D, D, D, (bf16*)(WB + W_O), D, scr, r, lane); continue; } r -= I_SQ;
                    if (r < I_1) { transpose_item(INP(10) + (size_t)layer * D * FF, FF, FF, (bf16*)(WB + W_1), D, scr, r, lane); continue; } r -= I_1;
                    if (r < I_2) { transpose_item(INP(11) + (size_t)layer * FF * D, D, D, (bf16*)(WB + W_2), FF, scr, r, lane); continue; } r -= I_2;
                    if (r < I_GLU) { transpose_item(INP(26) + (size_t)jj * 512 * 512, 512, 512, (bf16*)(WB + W_GLU), 512, scr, r, lane); continue; } r -= I_GLU;
                    transpose_item(INP(33) + (size_t)jj * 64 * 2048, 2048, 2048, (bf16*)(WB + W_3T), 128, scr, r, lane);
                }
                if (odd) { bf16* w3t = (bf16*)(WB + W_3T); for (int e = gt; e < 2048 * 64; e += GT) w3t[(size_t)(e >> 6) * 128 + 64 + (e & 63)] = 0; }
                if (!odd) {
                    const float* Wg = INP(13) + (size_t)jj * 4 * 128 * 128; const float* psc = INP(14) + (size_t)jj * 512;
                    for (int o = gt; o < D * 512; o += GT) { const int k = o >> 9, n = o & 511, gq = n >> 7, d = n & 127;
                        const float* wr_ = Win + (size_t)k * 2048 + gq * 128; const float* wg = Wg + (size_t)gq * 128 * 128 + d; float acc = 0.f;
#pragma unroll 8
                        for (int c = 0; c < 128; ++c) acc += wr_[c] * wg[c * 128];
                        ((bf16*)(WB + W_IN))[(size_t)n * D + k] = (bf16)f2bf(acc * psc[n]); }
                }
                for (int m = gw; m < NMEMT; m += NGW) norm_row(INP(1) + (size_t)m * D, nullptr, nullptr, nullptr, INP(4) + (size_t)layer * D, MN + (size_t)m * D, lane);
                if (layer == 0) {
                    for (int m = gw; m < T_TOK; m += NGW) norm_row(INP(0) + (size_t)m * D, X + (size_t)m * D, nullptr, nullptr, INP(2), HN + (size_t)m * D, lane);
                    for (int k = gt; k < 8192; k += GT) { float sn, cs; sincospif((float)k * (2.0f / 16384.0f), &sn, &cs); TW[k] = make_float2(cs, -sn); }
                }
                if (odd) {
                    __syncthreads();
                    float* zs = (float*)lds; float* h1s = zs + 8 * 36;
                    const float* w1 = INP(29) + (size_t)jj * 33 * 64; const float* b1 = INP(30) + jj * 64; const float* w2 = INP(31) + (size_t)jj * 64 * 64; const float* b2 = INP(32) + jj * 64; const float* fr = INP(34) + jj * 64;
                    for (int tb = bid; tb < L_SEQ / 8; tb += G) {
                        __syncthreads();
                        if (tid < 8 * 33) { const int tl = tid / 33, k = tid % 33, t = tb * 8 + tl; float z;
                            if (k == 0) z = (float)t / (float)(L_SEQ - 1);
                            else { const int bnd = (k - 1) & 15; const float band = 1e-4f + (float)bnd * ((15.0f - 1e-4f) / 15.0f); const float ang = ((float)(2.0 * 3.14159265358979323846 / L_SEQ) * (float)t) * band;
                                z = (k <= 16) ? cosf(ang) : -sinf(ang); }
                            zs[tl * 36 + k] = z; }
                        __syncthreads();
                        const int tl = tid >> 6, j = tid & 63;
                        { float a = b1[j];
                            for (int k = 0; k < 33; ++k) a += zs[tl * 36 + k] * w1[k * 64 + j];
                            h1s[tl * 64 + j] = sinf(fr[j] * a); }
                        __syncthreads();
                        { float a = b2[j];
                            for (int k = 0; k < 64; ++k) a += h1s[tl * 64 + k] * w2[k * 64 + j];
                            bf16* H2b = (bf16*)H2; H2b[(size_t)(tb * 8 + tl) * 128 + j] = (bf16)f2bf(sinf(fr[j] * a)); H2b[(size_t)(tb * 8 + tl) * 128 + 64 + j] = 0; }
                    }
                }
            } else if (op == OP_F3) {
                if (!odd) continue;
                float2* x = (float2*)lds; const float* KT = (const float*)(R + R_KT); unsigned* SPEC = (unsigned*)(R + R_SPEC);
                float2* twl = (float2*)(lds + TWL_OFF);
                for (int k = tid; k < 1024; k += 512) twl[k] = TW[k];
                for (int f = bid; f < 1024; f += G) {
                    __syncthreads();
                    const float* kr = KT + (size_t)f * NFFT;
                    for (int p = tid; p < NFFT; p += 512) { float v = (p == L_SEQ) ? 0.f : kr[p]; if (p == 0) v += KT0B[f]; x[PADI(p)] = make_float2(v, 0.f); }
                    __syncthreads();
                    fft_fwd(x, twl, tid);
                    float nsum; { const float* PART = (const float*)(ws + WS_PART) + (size_t)(f >> 9) * 1024 + (f & 511);
                        nsum = wave_sum(PART[(size_t)lane * 2048] + PART[(size_t)lane * 2048 + 512]); }
                    const float inv = 1.0f / ((nsum + 1e-6f) * (float)NFFT);
                    for (int p = tid; p < NFFT; p += 512) { const float2 a = x[PADI(p)]; SPEC[(size_t)f * NFFT + p] = pk2(a.x * inv, a.y * inv); }
                }
            } else if (op == OP_MIX1) {
                if (!odd) {
                    const bf16* P = (const bf16*)(R + R_P); const float* cw = INP(15) + (size_t)jj * 3 * 512;
                    for (int item = gt; item < T_TOK * 128; item += GT) {
                        const int row = item >> 7, c8 = item & 127, t = row & (L_SEQ - 1);
                        float o[8];
                        if (c8 < 64) {
                            const int c = c8 * 8, h = 1 << (c >> 7); const int lo = max(t - h, 0), hi = min(t + h, L_SEQ);
                            float s[8] = {0.f, 0.f, 0.f, 0.f, 0.f, 0.f, 0.f, 0.f};
                            const bf16* base = P + (size_t)(row - t) * 2048 + c;
                            for (int tau = lo; tau < hi; ++tau) { const u32x4 w = *(const u32x4*)(base + (size_t)tau * 2048);
                                s[0] += pg8::bfl(w.x); s[1] += pg8::bfh(w.x); s[2] += pg8::bfl(w.y); s[3] += pg8::bfh(w.y); s[4] += pg8::bfl(w.z); s[5] += pg8::bfh(w.z); s[6] += pg8::bfl(w.w); s[7] += pg8::bfh(w.w); }
                            const u32x4 w = *(const u32x4*)(base + (size_t)t * 2048); const float ic = 1.0f / (float)(hi - lo);
                            o[0] = s[0] * ic - pg8::bfl(w.x); o[1] = s[1] * ic - pg8::bfh(w.x); o[2] = s[2] * ic - pg8::bfl(w.y); o[3] = s[3] * ic - pg8::bfh(w.y);
                            o[4] = s[4] * ic - pg8::bfl(w.z); o[5] = s[5] * ic - pg8::bfh(w.z); o[6] = s[6] * ic - pg8::bfl(w.w); o[7] = s[7] * ic - pg8::bfh(w.w);
                        } else {
                            const int c = (c8 - 64) * 8; const bf16* pr = P + (size_t)row * 2048 + c;
                            float acc[8] = {0.f, 0.f, 0.f, 0.f, 0.f, 0.f, 0.f, 0.f};
#pragma unroll
                            for (int dt = -1; dt <= 1; ++dt) {
                                if (t + dt < 0 || t + dt >= L_SEQ) continue;
                                const u32x4 cg_ = *(const u32x4*)(pr + (ptrdiff_t)dt * 2048 + 1024), hv = *(const u32x4*)(pr + (ptrdiff_t)dt * 2048 + 1536);
                                const f32x4 wa = *(const f32x4*)(cw + (dt + 1) * 512 + c), wb = *(const f32x4*)(cw + (dt + 1) * 512 + c + 4);
                                acc[0] += wa.x * pg8::bfl(cg_.x) * pg8::bfl(hv.x); acc[1] += wa.y * pg8::bfh(cg_.x) * pg8::bfh(hv.x); acc[2] += wa.z * pg8::bfl(cg_.y) * pg8::bfl(hv.y); acc[3] += wa.w * pg8::bfh(cg_.y) * pg8::bfh(hv.y);
                                acc[4] += wb.x * pg8::bfl(cg_.z) * pg8::bfl(hv.z); acc[5] += wb.y * pg8::bfh(cg_.z) * pg8::bfh(hv.z); acc[6] += wb.z * pg8::bfl(cg_.w) * pg8::bfl(hv.w); acc[7] += wb.w * pg8::bfh(cg_.w) * pg8::bfh(hv.w);
                            }
                            const u32x4 bg = *(const u32x4*)(pr + 512);
                            o[0] = acc[0] * pg8::bfl(bg.x); o[1] = acc[1] * pg8::bfh(bg.x); o[2] = acc[2] * pg8::bfl(bg.y); o[3] = acc[3] * pg8::bfh(bg.y);
                            o[4] = acc[4] * pg8::bfl(bg.z); o[5] = acc[5] * pg8::bfh(bg.z); o[6] = acc[6] * pg8::bfl(bg.w); o[7] = acc[7] * pg8::bfh(bg.w);
                        }
                        u32x4 w; w.x = pk2(o[0], o[1]); w.y = pk2(o[2], o[3]); w.z = pk2(o[4], o[5]); w.w = pk2(o[6], o[7]);
                        *(u32x4*)(MIXIN + (size_t)row * D + c8 * 8) = w;
                    }
                } else {
                    s5_pass<false>(lds, tid, bid, G, (const bf16*)(R + R_PS5), S5F, nullptr, nullptr, INP(18) + (size_t)jj * 2 * 32 * 64, INP(19) + (size_t)jj * 2 * 32 * 64, INP(20) + (size_t)jj * 2 * 32,
                                   INP(21) + (size_t)jj * 32 * 64 * 16, INP(22) + (size_t)jj * 32 * 64 * 16, nullptr, nullptr, nullptr);
                    __syncthreads();
                    float2* x = (float2*)lds; const bf16* PT = (const bf16*)(R + R_PT); const unsigned* SPEC = (const unsigned*)(R + R_SPEC); bf16* YT = (bf16*)(R + R_YT);
                    const float* sw = INP(27) + (size_t)jj * 3 * 1536; const float* sbv = INP(28) + (size_t)jj * 1536; const float* hb = INP(35) + (size_t)jj * 2 * 512;
                    float2* twl = (float2*)(lds + TWL_OFF);
                    for (int k = tid; k < 1024; k += 512) twl[k] = TW[k];
                    for (int c = bid; c < 512; c += G) {
                        int tid_h = threadIdx.x; asm volatile("" : "+v"(tid_h));
                        const bf16* r_go = PT + (size_t)c * T_TOK; const bf16* r_gm = PT + (size_t)(512 + c) * T_TOK; const bf16* r_v = PT + (size_t)(1024 + c) * T_TOK;
                        const float go0 = sw[c], go1 = sw[1536 + c], go2 = sw[3072 + c], gob = sbv[c];
                        const float gm0 = sw[512 + c], gm1 = sw[1536 + 512 + c], gm2 = sw[3072 + 512 + c], gmb = sbv[512 + c];
                        const float v0 = sw[1024 + c], v1 = sw[1536 + 1024 + c], v2 = sw[3072 + 1024 + c], vb = sbv[1024 + c];
                        const float bias0 = hb[c], bias1 = hb[512 + c];
                        __syncthreads();
                        for (int t = tid_h; t < L_SEQ; t += 512) { x[PADI(t)] = make_float2(hy_sc(r_v, t, v0, v1, v2, vb), hy_sc(r_v + L_SEQ, t, v0, v1, v2, vb)); x[PADI(L_SEQ) + PADI(t)] = make_float2(0.f, 0.f); }
                        __syncthreads();
                        fft_fwd(x, twl, tid); spec_mul(x, SPEC + (size_t)c * NFFT, tid); fft_inv(x, twl, tid);
                        float2 zr[16];
#pragma unroll
                        for (int i = 0; i < 16; ++i) { const int t = tid_h + 512 * i; const float2 y1 = x[PADI(t)];
                            const float va = hy_sc(r_v, t, v0, v1, v2, vb), vbb = hy_sc(r_v + L_SEQ, t, v0, v1, v2, vb);
                            const float ga = hy_sc(r_gm, t, gm0, gm1, gm2, gmb), gb = hy_sc(r_gm + L_SEQ, t, gm0, gm1, gm2, gmb);
                            zr[i] = make_float2(ga * (y1.x + va * bias0), gb * (y1.y + vbb * bias0));
                            x[PADI(t)] = zr[i]; x[PADI(L_SEQ) + PADI(t)] = make_float2(0.f, 0.f); }
                        __syncthreads();
                        fft_fwd(x, twl, tid); spec_mul(x, SPEC + (size_t)(512 + c) * NFFT, tid); fft_inv(x, twl, tid);
#pragma unroll
                        for (int i = 0; i < 16; ++i) { const int t = tid_h + 512 * i; const float2 y2 = x[PADI(t)];
                            const float ga = hy_sc(r_go, t, go0, go1, go2, gob), gb = hy_sc(r_go + L_SEQ, t, go0, go1, go2, gob);
                            YT[(size_t)c * T_TOK + t] = (bf16)f2bf(ga * (y2.x + zr[i].x * bias1));
                            YT[(size_t)c * T_TOK + L_SEQ + t] = (bf16)f2bf(gb * (y2.y + zr[i].y * bias1)); }
                    }
                }
            } else if (op == OP_MIX2) {
                if (!odd) continue;
                s5_pass<true>(lds, tid, bid, G, (const bf16*)(R + R_PS5), S5F, (float*)(R + R_Y), (bf16*)(R + R_G), INP(18) + (size_t)jj * 2 * 32 * 64, INP(19) + (size_t)jj * 2 * 32 * 64, INP(20) + (size_t)jj * 2 * 32,
                              INP(21) + (size_t)jj * 32 * 64 * 16, INP(22) + (size_t)jj * 32 * 64 * 16, INP(23) + (size_t)jj * 2 * 32 * 16 * 64, INP(24) + (size_t)jj * 2 * 32 * 16 * 64, INP(25) + (size_t)jj * 512);
                __syncthreads();
                { bf16* ts = (bf16*)lds + wave * (64 * 66); const bf16* YT = (const bf16*)(R + R_YT);
                  for (int it = gw; it < 8 * 256; it += NGW) { const int cb = it & 7, tb = it >> 3;
                      for (int cl = 0; cl < 64; ++cl) ts[cl * 66 + lane] = YT[(size_t)(cb * 64 + cl) * T_TOK + tb * 64 + lane];
                      LDS_FENCE();
                      for (int tl = 0; tl < 64; ++tl) MIXIN[(size_t)(tb * 64 + tl) * D + 512 + cb * 64 + lane] = ts[lane * 66 + tl];
                      LDS_FENCE(); } }
            } else if (op == OP_SOFTMAX) {
                const float* SC = (const float*)(R + R_SC); bf16* PR = (bf16*)(R + R_PROB);
                for (int it = gw; it < T_TOK * 4; it += NGW) {
                    const f32x4 s = *((const f32x4*)(SC + (size_t)it * 256) + lane);
                    const float m = wave_max(fmaxf(fmaxf(s.x, s.y), fmaxf(s.z, s.w)));
                    const float e0 = __expf(s.x - m), e1 = __expf(s.y - m), e2 = __expf(s.z - m), e3 = __expf(s.w - m);
                    const float inv = 1.f / wave_sum((e0 + e1) + (e2 + e3));
                    u32x2 w; w.x = pk2(e0 * inv, e1 * inv); w.y = pk2(e2 * inv, e3 * inv);
                    *((u32x2*)(PR + (size_t)it * 256) + lane) = w;
                }
            } else if (op == OP_NORM_MIX || op == OP_NORM_XA || op == OP_NORM_MLP) {
                const float* gpost = (op == OP_NORM_MIX) ? INP(2) + (size_t)(layer * 2 + 1) * D : (op == OP_NORM_XA) ? INP(3) + (size_t)(layer * 2 + 1) * D : INP(5) + (size_t)(layer * 2 + 1) * D;
                const float* gpre = (op == OP_NORM_MIX) ? INP(3) + (size_t)(layer * 2) * D : (op == OP_NORM_XA) ? INP(5) + (size_t)(layer * 2) * D : INP(2) + (size_t)((layer + 1) * 2) * D;
                const bool want_hn = !(op == OP_NORM_MLP && layer == 3);
                for (int m = gw; m < T_TOK; m += NGW) norm_row(X + (size_t)m * D, X + (size_t)m * D, MIXOUT + (size_t)m * D, gpost, gpre, want_hn ? HN + (size_t)m * D : nullptr, lane);
            } else { continue; }
            GRID_SYNC();
        }
    }
}

extern "C" void kernel_launch(void* const* d_in, const int* in_sizes, int n_in, void* d_out, int out_size, void* d_ws, size_t ws_size, hipStream_t stream) {
    static int grid = 0;
    if (grid == 0) {
        if (n_in != 37 || out_size != T_TOK * D || ws_size < WS_END) { fprintf(stderr, "kernel_launch: unexpected shapes (n_in %d out %d ws %zu, need ws >= %zu)\n", n_in, out_size, ws_size, (size_t)WS_END); grid = -1; return; }
        int dev = 0, cus = 0, per_cu = 0;
        (void)hipGetDevice(&dev);
        (void)hipDeviceGetAttribute(&cus, hipDeviceAttributeMultiprocessorCount, dev);
        (void)hipFuncSetAttribute((const void*)fwd_kernel, hipFuncAttributeMaxDynamicSharedMemorySize, LDS_BYTES);
        (void)hipOccupancyMaxActiveBlocksPerMultiprocessor(&per_cu, (const void*)fwd_kernel, 512, LDS_BYTES);
        (void)hipGetLastError();
        grid = cus > 0 ? cus : 256;
        fprintf(stderr, "kernel_launch: grid %d (per_cu %d) ws %zu\n", grid, per_cu, ws_size);
    }
    if (grid < 0) return;
    if (hipMemsetAsync((char*)d_ws + WS_BAR, 0, WS_BAR_BYTES, stream) != hipSuccess) { fprintf(stderr, "kernel_launch: memset failed\n"); return; }
    Args a{};
    for (int i = 0; i < 37; ++i) a.in[i] = (const float*)d_in[i];
    a.out = (float*)d_out; a.ws = (unsigned char*)d_ws;
    void* kargs[] = {&a};
    hipError_t e = hipLaunchCooperativeKernel((void*)fwd_kernel, dim3(grid), dim3(512), kargs, LDS_BYTES, stream);
    if (e != hipSuccess) fprintf(stderr, "kernel_launch: cooperative launch failed: %s\n", hipGetErrorString(e));
}
```
